# Optimizing an MI355X kernel written in HIP

```python
import math
import jax, jax.numpy as jnp
from jax import lax
import numpy as np

D_MODEL = 2048
BATCH = 8
SEQ = 2048
DEPTH = 1

PLE_DIM = 256
A_HEADS = 8
A_QK_DIM = 64
A_V_DIM = 2 * A_QK_DIM
A_WIDTH = A_HEADS * A_V_DIM
Q_BLOCK = 128
R_HEADS = 16
R_HEAD = 64
R_WIDTH = R_HEADS * R_HEAD
DECAY_LORA = 64
ICLR_LORA = 64
GATE_LORA = 160
N_EXPERTS = 64
TOP_K = 8
EXPERT_FF = 512
SHARED_FF = 512
ROUTED_SCALE = 2.5
MOE_BLOCK = 128
RMS_EPS = 1e-6
GN_EPS = 64e-5
Q_COLS = A_HEADS * 2 * A_QK_DIM
A_COLS = 2 * Q_COLS + A_WIDTH
R_COLS = 3 * R_WIDTH + 2 * DECAY_LORA + 2 * ICLR_LORA + GATE_LORA
IN_COLS = A_COLS + R_COLS

kernel_name = "hybrid_diffattn_rwkv7_moe_block"


def rms_norm(x, g):
    xf = x.astype(jnp.float32)
    y = xf * lax.rsqrt(jnp.mean(xf * xf, axis=-1, keepdims=True) + RMS_EPS)
    return (y * g.astype(jnp.float32)).astype(x.dtype)


def alibi_slopes(n_heads):
    h = jnp.arange(1, n_heads + 1, dtype=jnp.float32)
    return jnp.exp2(-8.0 * h / n_heads)


def diff_attention(q, k, v, lam, subln_g, lambda_init):
    B, T, H, _, dk = q.shape
    dv = v.shape[-1]
    nq = T // Q_BLOCK
    scale = dk ** -0.5
    qb = q.reshape(B, nq, Q_BLOCK, H, 2, dk).transpose(1, 4, 0, 3, 2, 5)
    kt = k.transpose(3, 0, 2, 1, 4)
    vt = v.transpose(0, 2, 1, 3)
    slopes = alibi_slopes(H)
    kpos = jnp.arange(T)

    def one_block(args):
        qblk, blk = args
        qpos = blk * Q_BLOCK + jnp.arange(Q_BLOCK)
        dist = jnp.abs(qpos[:, None] - kpos[None, :]).astype(jnp.float32)
        bias = -slopes[:, None, None] * dist
        s = jnp.einsum('mbhqd,mbhkd->mbhqk', qblk, kt).astype(jnp.float32) * scale + bias
        prob = jax.nn.softmax(s, axis=-1)
        attn = prob[0] - lam * prob[1]
        return jnp.einsum('bhqk,bhkd->bhqd', attn.astype(vt.dtype), vt)

    o = lax.map(one_block, (qb, jnp.arange(nq)))
    o = o.transpose(1, 0, 3, 2, 4).reshape(B, T, H, dv)
    o = rms_norm(o, subln_g) * (1.0 - lambda_init)
    return o.reshape(B, T, H * dv)


def centred_shift(z, mu_prev, mu_next):
    zp = jnp.pad(z[:, :-1], ((0, 0), (1, 0), (0, 0)))
    zn = jnp.pad(z[:, 1:], ((0, 0), (0, 1), (0, 0)))
    return z + mu_prev * (zp - z) + mu_next * (zn - z)


def rwkv7_step(S, inp):
    r, w, kk, b, k, v = inp
    sa = jnp.einsum('dbhij,dbhj->dbhi', S, kk)
    S = S * w[..., None, :] - sa[..., :, None] * b[..., None, :] + v[..., :, None] * k[..., None, :]
    y = jnp.einsum('dbhij,dbhj->dbhi', S, r)
    return S, y


def rwkv7_bidir(z, w0, w_decay_up, a0, w_iclr_up, w_gate_up, k_k, k_a, r_k, ln_x_g, ln_x_b):
    B, T, _ = z.shape
    C, H, N = R_WIDTH, R_HEADS, R_HEAD
    f32 = jnp.float32
    o3 = 3 * C
    o4 = o3 + 2 * DECAY_LORA
    o5 = o4 + 2 * ICLR_LORA
    r = z[..., :C]
    k = z[..., C:2 * C]
    v = z[..., 2 * C:o3]
    lw = z[..., o3:o4].reshape(B, T, 2, DECAY_LORA)
    la = z[..., o4:o5].reshape(B, T, 2, ICLR_LORA)
    lg = z[..., o5:]
    zw = jnp.einsum('btdr,drc->dbtc', jnp.tanh(lw), w_decay_up) + w0[:, None, None, :]
    w = jnp.exp(-math.exp(-0.5) * jax.nn.sigmoid(zw.astype(f32)))
    a = jax.nn.sigmoid((jnp.einsum('btdr,drc->dbtc', la, w_iclr_up) + a0[:, None, None, :]).astype(f32))
    g = jax.nn.sigmoid(lg) @ w_gate_up
    kk = (k * k_k).astype(f32).reshape(B, T, H, N)
    kk = kk * lax.rsqrt(jnp.maximum(jnp.sum(kk * kk, axis=-1, keepdims=True), 1e-12))
    kk = kk.reshape(B, T, C)
    kt = k.astype(f32)[None] * (1.0 + (a - 1.0) * k_a.astype(f32))
    b = kk[None] * a

    def to_scan(u):
        u = jnp.broadcast_to(u, (2, B, T, C))
        u = jnp.stack([u[0], jnp.flip(u[1], axis=1)]).astype(f32)
        return u.reshape(2, B, T, H, N).transpose(2, 0, 1, 3, 4)

    xs = (to_scan(r), to_scan(w), to_scan(kk), to_scan(b), to_scan(kt), to_scan(v))
    s0 = jnp.zeros((2, B, H, N, N), f32)
    _, ys = lax.scan(rwkv7_step, s0, xs)
    ys = ys.transpose(1, 2, 0, 3, 4)
    y = ys[0] + jnp.flip(ys[1], axis=1)
    mu = jnp.mean(y, axis=-1, keepdims=True)
    var = jnp.mean(jnp.square(y - mu), axis=-1, keepdims=True)
    yn = ((y - mu) * lax.rsqrt(var + GN_EPS)).reshape(B, T, C) * ln_x_g + ln_x_b
    rh = r.astype(f32).reshape(B, T, H, N)
    coef = jnp.sum(rh[None] * kt.reshape(2, B, T, H, N) * r_k.astype(f32), axis=(0, 4))
    bonus = (coef[..., None] * v.astype(f32).reshape(B, T, H, N)).reshape(B, T, C)
    return ((yn + bonus) * g.astype(f32)).astype(z.dtype)


def moe_ffn(xf, w_router, b_router, w_e_gate, w_e_up, w_e_down, w_s_gate, w_s_up, w_s_down):
    n_tok, d = xf.shape
    scores = jax.nn.sigmoid((xf @ w_router).astype(jnp.float32))
    _, idx = lax.top_k(scores + b_router.astype(jnp.float32), TOP_K)
    gsel = jnp.take_along_axis(scores, idx, axis=-1)
    gsel = gsel / jnp.sum(gsel, axis=-1, keepdims=True) * ROUTED_SCALE
    m = n_tok * TOP_K
    e_flat = idx.reshape(m)
    tok_flat = jnp.repeat(jnp.arange(n_tok, dtype=jnp.int32), TOP_K)
    g_flat = gsel.reshape(m)
    order = jnp.argsort(e_flat)
    e_s, tok_s, g_s = e_flat[order], tok_flat[order], g_flat[order]
    counts = jnp.bincount(e_flat, length=N_EXPERTS)
    starts = jnp.cumsum(counts) - counts
    padded = (counts + MOE_BLOCK - 1) // MOE_BLOCK * MOE_BLOCK
    pends = jnp.cumsum(padded)
    pstarts = pends - padded
    dest = pstarts[e_s] + jnp.arange(m) - starts[e_s]
    n_blocks = -(-m // MOE_BLOCK) + N_EXPERTS
    cap = n_blocks * MOE_BLOCK
    slot_tok = jnp.zeros((cap,), jnp.int32).at[dest].set(tok_s)
    slot_g = jnp.zeros((cap,), jnp.float32).at[dest].set(g_s)
    block_e = jnp.minimum(jnp.searchsorted(pends, jnp.arange(n_blocks) * MOE_BLOCK, side='right'),
                          N_EXPERTS - 1)

    def expert_block(args):
        tok, gb, e = args
        xb = xf[tok]
        hb = jax.nn.silu(xb @ w_e_gate[e]) * (xb @ w_e_up[e])
        return (hb @ w_e_down[e]) * gb[:, None].astype(xf.dtype)

    yb = lax.map(expert_block, (slot_tok.reshape(n_blocks, MOE_BLOCK),
                                slot_g.reshape(n_blocks, MOE_BLOCK), block_e))
    routed = jax.ops.segment_sum(yb.reshape(cap, d), slot_tok, num_segments=n_tok)
    shared = (jax.nn.silu(xf @ w_s_gate) * (xf @ w_s_up)) @ w_s_down
    return routed + shared


def setup_inputs(seed: int = 0) -> dict:
    key = jax.random.key(seed)
    ks = iter(jax.random.split(key, 48))
    f32 = jnp.float32
    L, D = DEPTH, D_MODEL

    def nrm(shape, scale):
        return jax.random.normal(next(ks), shape, f32) * scale

    def gain(shape):
        return 1.0 + 0.02 * jax.random.normal(next(ks), shape, f32)

    def unif(shape, lo, hi):
        return jax.random.uniform(next(ks), shape, f32, lo, hi)

    return {
        "x": nrm((BATCH, SEQ, D), 1.0),
        "p": nrm((L, BATCH, SEQ, PLE_DIM), 1.0),
        "norm_mix_g": gain((L, D)),
        "w_in": nrm((L, D, IN_COLS), D ** -0.5),
        "w_branch_gate": nrm((L, D, 2 * D), D ** -0.5),
        "lambda_q1": nrm((L, A_QK_DIM), 0.1),
        "lambda_k1": nrm((L, A_QK_DIM), 0.1),
        "lambda_q2": nrm((L, A_QK_DIM), 0.1),
        "lambda_k2": nrm((L, A_QK_DIM), 0.1),
        "subln_g": gain((L, A_V_DIM)),
        "shift_prev": unif((L, R_COLS), 0.0, 0.5),
        "shift_next": unif((L, R_COLS), 0.0, 0.5),
        "w0": unif((L, 2, R_WIDTH), -4.0, 2.0),
        "w_decay_up": nrm((L, 2, DECAY_LORA, R_WIDTH), 0.5 * DECAY_LORA ** -0.5),
        "a0": nrm((L, 2, R_WIDTH), 0.5),
        "w_iclr_up": nrm((L, 2, ICLR_LORA, R_WIDTH), 0.5 * ICLR_LORA ** -0.5),
        "w_gate_up": nrm((L, GATE_LORA, R_WIDTH), GATE_LORA ** -0.5),
        "k_k": 0.85 + nrm((L, R_WIDTH), 0.1),
        "k_a": 1.0 + nrm((L, R_WIDTH), 0.1),
        "r_k": nrm((L, R_HEADS, R_HEAD), 0.1),
        "ln_x_g": gain((L, R_WIDTH)),
        "ln_x_b": nrm((L, R_WIDTH), 0.02),
        "w_br_attn": nrm((L, A_WIDTH, D), A_WIDTH ** -0.5),
        "w_br_rwkv": nrm((L, R_WIDTH, D), R_WIDTH ** -0.5),
        "w_out": nrm((L, D, D), D ** -0.5),
        "norm_ffn_g": gain((L, D)),
        "w_router": nrm((L, D, N_EXPERTS), D ** -0.5),
        "b_router": nrm((L, N_EXPERTS), 0.01),
        "w_e_gate": nrm((L, N_EXPERTS, D, EXPERT_FF), D ** -0.5),
        "w_e_up": nrm((L, N_EXPERTS, D, EXPERT_FF), D ** -0.5),
        "w_e_down": nrm((L, N_EXPERTS, EXPERT_FF, D), EXPERT_FF ** -0.5),
        "w_s_gate": nrm((L, D, SHARED_FF), D ** -0.5),
        "w_s_up": nrm((L, D, SHARED_FF), D ** -0.5),
        "w_s_down": nrm((L, SHARED_FF, D), SHARED_FF ** -0.5),
        "norm_ple_g": gain((L, D)),
        "w_ple_gate": nrm((L, D, D), D ** -0.5),
        "w_ple_proj": nrm((L, PLE_DIM, D), PLE_DIM ** -0.5),
        "norm_final_g": gain((D,)),
    }


def reference(x, p, norm_mix_g, w_in, w_branch_gate, lambda_q1, lambda_k1, lambda_q2, lambda_k2,
              subln_g, shift_prev, shift_next, w0, w_decay_up, a0, w_iclr_up, w_gate_up, k_k, k_a,
              r_k, ln_x_g, ln_x_b, w_br_attn, w_br_rwkv, w_out, norm_ffn_g, w_router, b_router,
              w_e_gate, w_e_up, w_e_down, w_s_gate, w_s_up, w_s_down, norm_ple_g, w_ple_gate,
              w_ple_proj, norm_final_g):
    B, T, D = x.shape
    f32 = jnp.float32
    h = x
    for i in range(DEPTH):
        lambda_init = 0.8 - 0.6 * math.exp(-0.3 * i)
        u = rms_norm(h, norm_mix_g[i])
        z = u @ w_in[i]
        za, zr = z[..., :A_COLS], z[..., A_COLS:]
        q = za[..., :Q_COLS].reshape(B, T, A_HEADS, 2, A_QK_DIM)
        k = za[..., Q_COLS:2 * Q_COLS].reshape(B, T, A_HEADS, 2, A_QK_DIM)
        v = za[..., 2 * Q_COLS:].reshape(B, T, A_HEADS, A_V_DIM)
        lam = (jnp.exp(jnp.sum(lambda_q1[i].astype(f32) * lambda_k1[i].astype(f32)))
               - jnp.exp(jnp.sum(lambda_q2[i].astype(f32) * lambda_k2[i].astype(f32)))
               + lambda_init)
        ya = diff_attention(q, k, v, lam, subln_g[i], lambda_init)
        zr = centred_shift(zr, shift_prev[i], shift_next[i])
        yr = rwkv7_bidir(zr, w0[i], w_decay_up[i], a0[i], w_iclr_up[i], w_gate_up[i],
                         k_k[i], k_a[i], r_k[i], ln_x_g[i], ln_x_b[i])
        gates = jax.nn.sigmoid(u @ w_branch_gate[i])
        merged = gates[..., :D] * (ya @ w_br_attn[i]) + gates[..., D:] * (yr @ w_br_rwkv[i])
        h = h + merged @ w_out[i]
        u = rms_norm(h, norm_ffn_g[i])
        y_ffn = moe_ffn(u.reshape(B * T, D), w_router[i], b_router[i], w_e_gate[i], w_e_up[i],
                        w_e_down[i], w_s_gate[i], w_s_up[i], w_s_down[i])
        h = h + y_ffn.reshape(B, T, D)
        u = rms_norm(h, norm_ple_g[i])
        h = h + jax.nn.sigmoid(u @ w_ple_gate[i]) * (p[i] @ w_ple_proj[i])
    return rms_norm(h, norm_final_g)
```

```cpp
#include <hip/hip_runtime.h>
#include <cstdio>
#include <cstdint>

#ifndef MK_ONE_LAUNCH
#define MK_ONE_LAUNCH 1
#endif

#define GAS __attribute__((address_space(1)))
#define LAS __attribute__((address_space(3)))
typedef unsigned short bf16;
typedef short bf16x8 __attribute__((ext_vector_type(8)));
typedef float f32x2 __attribute__((ext_vector_type(2)));
typedef float f32x4 __attribute__((ext_vector_type(4)));
typedef float f32x16 __attribute__((ext_vector_type(16)));
typedef unsigned u32x2 __attribute__((ext_vector_type(2)));
typedef unsigned u32x4 __attribute__((ext_vector_type(4)));

constexpr int NTOK = 16384, DM = 2048, SEQ = 2048, NB = 8;
constexpr int ZLD = 6656;
constexpr int ZR = 3072;
constexpr int RC = 3488;
constexpr int GLD = 4096;
constexpr int N1 = ZLD + GLD;
constexpr int NEXP = 64, TOPK = 8, EFF = 512;
constexpr int RCAP = 147456;
constexpr int SLOTS = RCAP + NTOK;
constexpr float RMS_EPS = 1e-6f, GN_EPS = 64e-5f;
constexpr float LOG2E = 1.4426950408889634f;

constexpr size_t MiB = 1u << 20;
constexpr size_t WS_CTL = 0, CTL_BYTES = 1 * MiB;
constexpr size_t WS_TOPI = 1 * MiB, WS_TOPG = WS_TOPI + 512 * 1024, WS_WGCNT = 2 * MiB, WS_MISC = WS_WGCNT + 64 * 1024;
constexpr size_t WS_SLOT_TOK = 3 * MiB, WS_SLOT_DST = 4 * MiB, WS_SLOT_G = 5 * MiB;
constexpr size_t WS_WRT = 7 * MiB, WS_WL = 8 * MiB, WL_BYTES = 5120 * 256 * 2;
constexpr size_t WS_PB = 11 * MiB, WS_WPP = 19 * MiB, WS_WPG = 27 * MiB, WS_WOUT = 35 * MiB, WS_WBR = 43 * MiB, WS_W1 = 51 * MiB;
constexpr size_t WS_Z = 93 * MiB, WS_U = 301 * MiB;
constexpr size_t WS_WUP = 93 * MiB, WS_WDN = 223 * MiB, WS_YR = 288 * MiB;
constexpr size_t WS_GATES = 365 * MiB, WS_YA = 493 * MiB, WS_R = 525 * MiB, WS_V = 557 * MiB, WS_KK = 589 * MiB, WS_WD = 621 * MiB, WS_KT = 749 * MiB, WS_BV = 813 * MiB, WS_G = 877 * MiB;
constexpr size_t WS_KS = 909 * MiB, WS_AP = 941 * MiB, WS_VT = 957 * MiB;
constexpr size_t WS_YS = 909 * MiB, WS_MERGED = 621 * MiB;
constexpr size_t WS_HRES = 877 * MiB  , WS_HB = 365 * MiB, WS_Y = 445 * MiB  , WS_PBUF = 749 * MiB;
constexpr size_t WS_END = 1037 * MiB;
constexpr size_t WS_W1G8 = WS_W1 + (size_t)ZLD * 2048 * 2;
constexpr size_t WS_U8E = WS_R;
constexpr int MI_TOTAL = 0, MI_PADDED = 64, MI_PSTART = 128, MI_NT = 192, MI_TILE_E = 1024, MI_TILE_R0 = 2048;
constexpr int CW_BAR = 4096, CW_QKN = 1024;

constexpr int RING_BYTES = 131072, LDSCTL_OFF = 143360, LDS_BYTES = 147456;

__device__ __forceinline__ unsigned cvt_pk_bf16(float lo, float hi) { unsigned r; asm("v_cvt_pk_bf16_f32 %0, %1, %2" : "=v"(r) : "v"(lo), "v"(hi)); return r; }
typedef __bf16 bf16x2v __attribute__((ext_vector_type(2)));
__device__ __forceinline__ unsigned cvt_pk_bf16_hz(float lo, float hi) { return __builtin_bit_cast(unsigned, __builtin_convertvector((f32x2){lo, hi}, bf16x2v)); }
__device__ __forceinline__ float bflo(unsigned w) { return __builtin_bit_cast(float, w << 16); }
__device__ __forceinline__ float bfhi(unsigned w) { return __builtin_bit_cast(float, w & 0xffff0000u); }
__device__ __forceinline__ float ex2(float x) { return __builtin_amdgcn_exp2f(x); }
__device__ __forceinline__ float sigm(float x) { return __builtin_amdgcn_rcpf(1.0f + ex2(-x * LOG2E)); }
constexpr int DPP_X1 = 0xB1, DPP_X2 = 0x4E, DPP_HM = 0x141, DPP_RM = 0x140;
template <int CTRL> __device__ __forceinline__ float dppf(float x) { return __builtin_bit_cast(float, __builtin_amdgcn_update_dpp(0, __builtin_bit_cast(int, x), CTRL, 0xf, 0xf, false)); }
template <int CTRL> __device__ __forceinline__ int dppi(int x) { return __builtin_amdgcn_update_dpp(0, x, CTRL, 0xf, 0xf, false); }
__device__ __forceinline__ float quad_sum(float v) { v += dppf<DPP_X1>(v); v += dppf<DPP_X2>(v); return v; }
__device__ __forceinline__ float row16_sum(float v) { v += dppf<DPP_X1>(v); v += dppf<DPP_X2>(v); v += dppf<DPP_HM>(v); v += dppf<DPP_RM>(v); return v; }
__device__ __forceinline__ float row16_max(float v) { v = fmaxf(v, dppf<DPP_X1>(v)); v = fmaxf(v, dppf<DPP_X2>(v)); v = fmaxf(v, dppf<DPP_HM>(v)); v = fmaxf(v, dppf<DPP_RM>(v)); return v; }
__device__ __forceinline__ float wave_sum(float v) { v = row16_sum(v); v += __shfl_xor(v, 16); v += __shfl_xor(v, 32); return v; }
__device__ __forceinline__ void unpack8(const u32x4 w, float (&f)[8]) { f[0] = bflo(w.x); f[1] = bfhi(w.x); f[2] = bflo(w.y); f[3] = bfhi(w.y); f[4] = bflo(w.z); f[5] = bfhi(w.z); f[6] = bflo(w.w); f[7] = bfhi(w.w); }
__device__ __forceinline__ u32x4 pack8(const float (&f)[8]) { u32x4 w; w.x = cvt_pk_bf16(f[0], f[1]); w.y = cvt_pk_bf16(f[2], f[3]); w.z = cvt_pk_bf16(f[4], f[5]); w.w = cvt_pk_bf16(f[6], f[7]); return w; }
#define dpp_f(v, ctrl) __builtin_bit_cast(float, __builtin_amdgcn_update_dpp(__builtin_bit_cast(int, (v)), __builtin_bit_cast(int, (v)), (ctrl), 0xF, 0xF, true))
#define PIN(x) asm("" : "+v"(x))
__device__ __forceinline__ void fmac_(float& acc, float a, float b) { asm("v_fmac_f32 %0, %1, %2" : "+v"(acc) : "v"(a), "v"(b)); }
__device__ __forceinline__ float fmul_(float a, float b) { float r; asm("v_mul_f32 %0, %1, %2" : "=v"(r) : "v"(a), "v"(b)); return r; }
__device__ __forceinline__ float fma3_(float a, float b, float c) { float r; asm("v_fma_f32 %0, %1, %2, %3" : "=v"(r) : "v"(a), "v"(b), "v"(c)); return r; }
__device__ __forceinline__ unsigned pk4_fp8(float a, float b, float c, float d) { int w = 0; w = __builtin_amdgcn_cvt_pk_fp8_f32(a, b, w, false); w = __builtin_amdgcn_cvt_pk_fp8_f32(c, d, w, true); return (unsigned)w; }
#define LDS_WAIT() asm volatile("s_waitcnt lgkmcnt(0)" ::: "memory")
#define VM_WAIT() asm volatile("s_waitcnt vmcnt(0)" ::: "memory")

#define XB_TMO      128
#define XB_XCNT(j)  (256  + 64 * (j))
#define XB_XSUB(j)  (1280 + 64 * (j))
#define XB_XGEN(j)  (2304 + 64 * (j))
#define XB_TOP      3328
#define XB_TOPGEN   3392
#define XCD_BAR_WORDS 3456
#define XB_SPIN_CAP (1u << 22)
__device__ __forceinline__ unsigned xb_ld(unsigned* p)              { return __hip_atomic_load(p, __ATOMIC_RELAXED, __HIP_MEMORY_SCOPE_AGENT); }
__device__ __forceinline__ unsigned xb_add(unsigned* p, unsigned v) { return __hip_atomic_fetch_add(p, v, __ATOMIC_RELAXED, __HIP_MEMORY_SCOPE_AGENT); }
__device__ __forceinline__ unsigned xb_xcc_id() { return (unsigned)__builtin_amdgcn_s_getreg((3 << 11) | 20) & 0xFu; }
#define XB_SPIN(cond, bar) do { unsigned _sp = 0; while (cond) { __builtin_amdgcn_s_sleep(1); \
    if ((++_sp & 255u) == 0u) { if (xb_ld(&(bar)[XB_TMO])) break; if (_sp > XB_SPIN_CAP) { atomicAdd(&(bar)[XB_TMO], 1u); break; } } } } while (0)
struct XcdBarrier { unsigned* bar; unsigned x; volatile LAS unsigned* st; };
__device__ __forceinline__ XcdBarrier xcd_barrier_post(unsigned* bar, volatile LAS unsigned* st) {
    XcdBarrier b; b.bar = bar; b.x = xb_xcc_id(); b.st = st;
    if (threadIdx.x == 0) (void)xb_add(&bar[XB_XCNT(b.x)], 1u);
    return b;
}
__device__ __forceinline__ void xcd_barrier_complete(unsigned* bar, unsigned x, unsigned& nloc, unsigned& nx) {
    const unsigned G = gridDim.x * gridDim.y * gridDim.z;
    unsigned sum, cnt, mine, sp = 0u;
    for (;;) {
        sum = 0u; cnt = 0u; mine = 0u;
#pragma unroll
        for (unsigned j = 0; j < 16; ++j) { const unsigned c = xb_ld(&bar[XB_XCNT(j)]); sum += c; cnt += (c > 0u) ? 1u : 0u; mine = (j == x) ? c : mine; }
        if (sum == G) break;
        __builtin_amdgcn_s_sleep(1);
        if ((++sp & 255u) == 0u) { if (xb_ld(&bar[XB_TMO])) break; if (sp > XB_SPIN_CAP) { atomicAdd(&bar[XB_TMO], 1u); break; } }
    }
    nloc = mine > 0u ? mine : 1u; nx = cnt > 0u ? cnt : 1u;
}
__device__ __forceinline__ void xcd_barrier(const XcdBarrier& b) {
    asm volatile("s_waitcnt vmcnt(0)" ::: "memory");
    __syncthreads();
    if (threadIdx.x == 0) {
        unsigned* bar = b.bar;
        __builtin_amdgcn_s_waitcnt(0);
        unsigned nloc = b.st[0], nx = b.st[1];
        if (nloc == 0u) { xcd_barrier_complete(bar, b.x, nloc, nx); b.st[0] = nloc; b.st[1] = nx; }
        const unsigned old = xb_add(&bar[XB_XSUB(b.x)], 1u);
        const unsigned gen = old / nloc;
        if (old + 1u == (gen + 1u) * nloc) {
            __builtin_amdgcn_fence(__ATOMIC_RELEASE, "agent");
            asm volatile("s_waitcnt vmcnt(0)" ::: "memory");
            const unsigned og = xb_add(&bar[XB_TOP], 1u);
            const unsigned tg = og / nx;
            if (og + 1u == (tg + 1u) * nx) xb_add(&bar[XB_TOPGEN], 1u);
            else XB_SPIN(xb_ld(&bar[XB_TOPGEN]) == tg, bar);
            __builtin_amdgcn_fence(__ATOMIC_ACQUIRE, "agent");
            xb_add(&bar[XB_XGEN(b.x)], 1u);
            asm volatile("s_waitcnt vmcnt(0)" ::: "memory");
        } else {
            XB_SPIN(xb_ld(&bar[XB_XGEN(b.x)]) == gen, bar);
            __builtin_amdgcn_fence(__ATOMIC_ACQUIRE, "agent");
            asm volatile("s_waitcnt vmcnt(0)" ::: "memory");
        }
    }
    __syncthreads();
}

namespace pg8 {
constexpr int BM = 256, BK = 64, HALF = 128, HTB = HALF * BK * 2, STAGE_BYTES = 8 * HTB, NXCD = 8, WGM = 8;
__device__ __forceinline__ int lds_byte(int r, int c) { const int st = (r >> 4) * 2 + (c >> 5), rr = r & 15, cc = c & 31, ob = rr * 64 + cc * 2; return st * 1024 + (ob ^ (((ob >> 9) & 1) << 5)); }
__device__ __forceinline__ void stage_rc(int b, int& R, int& C) { const int st = b / 1024, sb = b % 1024, swz = sb ^ (((sb >> 9) & 1) << 5); R = (st >> 1) * 16 + swz / 64; C = (st & 1) * 32 + (swz % 64) / 2; }
__device__ __forceinline__ int perm32(int rho) { const int n = rho >> 4, i = rho & 15; return 8 * (i >> 2) + 4 * n + (i & 3); }
struct Unit { int pm, pn, s, x; };
__device__ __forceinline__ void static_tile(int L, int nM, int nN, int& pm, int& pn) {
    const int nwg = nM * nN; int wgid = L;
    { const int q = nwg / NXCD, r = nwg % NXCD, xcd = wgid % NXCD, off = wgid / NXCD; wgid = (xcd < r ? xcd * (q + 1) : r * (q + 1) + (xcd - r) * q) + off; }
    const int nig = WGM * nN, gid = wgid / nig, fm = gid * WGM, gsz = (nM - fm) < WGM ? (nM - fm) : WGM;
    pm = fm + ((wgid % nig) % gsz); pn = (wgid % nig) / gsz;
}
typedef int v8i __attribute__((ext_vector_type(8)));
template <class Epi, class Sched, bool FP8 = false>
__device__ __forceinline__ void gemm_phase(LAS unsigned char* lds, const Sched& S, const Epi& E) {
    int tid = threadIdx.x; asm volatile("" : "+v"(tid));
    const int wid = __builtin_amdgcn_readfirstlane(tid >> 6), lane = tid & 63, wr = wid >> 2, wc = wid & 3, fr = lane & 15, fq = lane >> 4;
    const int ldb = S.ldb;
    int RA[2]; unsigned CA2[2], voffB[2];
#pragma unroll
    for (int i = 0; i < 2; ++i) { int R, C; stage_rc(tid * 16 + i * 8192, R, C); const int Rb = (R & ~31) + perm32(R & 31);
        RA[i] = R; CA2[i] = (unsigned)C * 2u; voffB[i] = FP8 ? (unsigned)(Rb * ldb + C * 2) : (unsigned)(Rb * ldb + C) * 2u; }
    const size_t kstep = (size_t)(BK * 2);
    const size_t hstepB = FP8 ? (size_t)HALF * ldb : (size_t)HALF * ldb * 2;
    const unsigned ldsw = (unsigned)wid * 1024u;
    const int aoff = lds_byte(wr * 64 + fr, fq * 8), boff = lds_byte(wc * 32 + fr, fq * 8);
#define PG8_SA(b, h) (((b) * 2 + (h)) * HTB)
#define PG8_SB(b, h) ((4 + (b) * 2 + (h)) * HTB)
#define PG8_STAGE(bufoff, gbase, voff) do { _Pragma("unroll") for (int _i = 0; _i < 2; ++_i) \
        __builtin_amdgcn_global_load_lds((const unsigned*)((const char*)(gbase) + (voff)[_i]), (LAS unsigned*)(lds + (bufoff) + ldsw + _i * 8192), 16, 0, 0); } while (0)
#define PG8_LD8(p) __builtin_bit_cast(v8i, __builtin_shufflevector(*(const LAS u32x4*)(p), *(const LAS u32x4*)((p) + 1024), 0, 1, 2, 3, 4, 5, 6, 7))
#define PG8_LDA(dst, b, h) do { if constexpr (FP8) { _Pragma("unroll") for (int m = 0; m < 4; ++m) dst##8[m] = PG8_LD8(lds + PG8_SA(b, h) + aoff + m * 2048); } \
        else { _Pragma("unroll") for (int m = 0; m < 4; ++m) _Pragma("unroll") for (int k = 0; k < 2; ++k) dst[m][k] = *(const LAS bf16x8*)(lds + PG8_SA(b, h) + aoff + m * 2048 + k * 1024); } } while (0)
#define PG8_LDB(dst, b, h) do { if constexpr (FP8) { _Pragma("unroll") for (int n = 0; n < 2; ++n) dst##8[n] = PG8_LD8(lds + PG8_SB(b, h) + boff + n * 2048); } \
        else { _Pragma("unroll") for (int n = 0; n < 2; ++n) _Pragma("unroll") for (int k = 0; k < 2; ++k) dst[n][k] = *(const LAS bf16x8*)(lds + PG8_SB(b, h) + boff + n * 2048 + k * 1024); } } while (0)
#define PG8_MMA(ai, bj, At, Bt) do { __builtin_amdgcn_s_setprio(1); _Pragma("unroll") for (int m = 0; m < 4; ++m) _Pragma("unroll") for (int n = 0; n < 2; ++n) { \
        if constexpr (FP8) asm volatile("v_mfma_scale_f32_16x16x128_f8f6f4 %0, %1, %2, %0, %3, %4 op_sel_hi:[0,0,0]" : "+v"(acc[ai][bj][m][n]) : "v"(Bt##8[n]), "v"(At##8[m]), "v"(wscale), "v"(ascale)); \
        else { _Pragma("unroll") for (int k = 0; k < 2; ++k) acc[ai][bj][m][n] = __builtin_amdgcn_mfma_f32_16x16x32_bf16(Bt[n][k], At[m][k], acc[ai][bj][m][n], 0, 0, 0); } } __builtin_amdgcn_s_setprio(0); } while (0)
#define PG8_WAIT_V(n) asm volatile("s_waitcnt vmcnt(" #n ")" ::: "memory")
#define PG8_WAIT_L(n) asm volatile("s_waitcnt lgkmcnt(" #n ")" ::: "memory")
#define PG8_BAR __builtin_amdgcn_s_barrier()
#define PG8_SCHED __builtin_amdgcn_sched_barrier(0)
    Unit cur, nxt; int ui = 0;
    if (!S.next(0, cur)) return;
    int wscale = 0x7F7F7F7F, ascale = 0x7F7F7F7F; if constexpr (FP8) wscale = S.wscale;
    f32x4 acc[2][2][4][2];
#pragma unroll
    for (int a = 0; a < 2; ++a)
#pragma unroll
        for (int b = 0; b < 2; ++b)
#pragma unroll
            for (int m = 0; m < 4; ++m)
#pragma unroll
                for (int n = 0; n < 2; ++n) acc[a][b][m][n] = (f32x4){0.f, 0.f, 0.f, 0.f};
    bf16x8 At[4][2], B0[2][2], B1[2][2]; v8i At8[4], B08[2], B18[2];
    unsigned vC[2][2], vN[2][2];
#pragma unroll
    for (int h = 0; h < 2; ++h)
#pragma unroll
        for (int i = 0; i < 2; ++i) vC[h][i] = S.arow(cur, h * HALF + RA[i]) + CA2[i];
    const char* cA = S.aptr(cur); const char* cB = S.bptr(cur);
    PG8_STAGE(PG8_SB(0, 0), cB, voffB); PG8_STAGE(PG8_SB(0, 1), cB + hstepB, voffB); PG8_STAGE(PG8_SA(0, 0), cA, vC[0]); PG8_STAGE(PG8_SA(0, 1), cA, vC[1]);
    if (wr == 1) PG8_BAR;
    PG8_WAIT_V(2); PG8_BAR;
    PG8_STAGE(PG8_SB(1, 0), cB + kstep, voffB); PG8_STAGE(PG8_SA(1, 0), cA + kstep, vC[0]); PG8_STAGE(PG8_SB(1, 1), cB + hstepB + kstep, voffB);
    PG8_WAIT_V(6); PG8_BAR;
    for (;;) {
        const bool has_next = S.next(ui + 1, nxt);
        const char* nA = cA; const char* nB = cB;
        if constexpr (Sched::VARROW) {
#pragma unroll
            for (int h = 0; h < 2; ++h)
#pragma unroll
                for (int i = 0; i < 2; ++i) vN[h][i] = vC[h][i]; }
        if (has_next) { nA = S.aptr(nxt); nB = S.bptr(nxt);
            if constexpr (Sched::VARROW) {
#pragma unroll
                for (int h = 0; h < 2; ++h)
#pragma unroll
                    for (int i = 0; i < 2; ++i) vN[h][i] = S.arow(nxt, h * HALF + RA[i]) + CA2[i]; } }
        const int nt = S.nt(cur);
#pragma nounroll
        for (int t = 0; t < nt; t += 2) {
            const bool last = (t == nt - 2);
            const char* a1 = cA + (size_t)(t + 1) * kstep;
            const char* a2 = last ? nA : cA + (size_t)(t + 2) * kstep; const char* b2 = last ? nB : cB + (size_t)(t + 2) * kstep;
            const char* a3 = a2 + kstep; const char* b3 = b2 + kstep;
            unsigned v2[2][2];
#pragma unroll
            for (int h = 0; h < 2; ++h)
#pragma unroll
                for (int i = 0; i < 2; ++i) { if constexpr (Sched::VARROW) v2[h][i] = last ? vN[h][i] : vC[h][i]; else v2[h][i] = vC[h][i]; }
            PG8_LDB(B0, 0, 0); PG8_LDB(B1, 0, 1); PG8_SCHED; PG8_LDA(At, 0, 0); PG8_STAGE(PG8_SA(1, 1), a1, vC[1]);
            PG8_WAIT_V(8); PG8_WAIT_L(0); PG8_BAR; PG8_MMA(0, 0, At, B0); PG8_MMA(0, 1, At, B1); PG8_BAR; PG8_SCHED;
            PG8_LDA(At, 0, 1); PG8_STAGE(PG8_SB(0, 0), b2, voffB); PG8_STAGE(PG8_SB(0, 1), b2 + hstepB, voffB); PG8_STAGE(PG8_SA(0, 0), a2, v2[0]);
            PG8_WAIT_V(8); PG8_WAIT_L(0); PG8_BAR; PG8_MMA(1, 0, At, B0); PG8_MMA(1, 1, At, B1); PG8_BAR; PG8_SCHED;
            PG8_LDB(B0, 1, 0); PG8_LDB(B1, 1, 1); PG8_SCHED; PG8_LDA(At, 1, 0); PG8_STAGE(PG8_SA(0, 1), a2, v2[1]);
            PG8_WAIT_V(8); PG8_WAIT_L(0); PG8_BAR; PG8_MMA(0, 0, At, B0); PG8_MMA(0, 1, At, B1); PG8_BAR; PG8_SCHED;
            PG8_LDA(At, 1, 1); PG8_STAGE(PG8_SB(1, 0), b3, voffB); PG8_STAGE(PG8_SB(1, 1), b3 + hstepB, voffB); PG8_STAGE(PG8_SA(1, 0), a3, v2[0]);
            PG8_WAIT_V(8); PG8_WAIT_L(0); PG8_BAR; PG8_MMA(1, 0, At, B0); PG8_MMA(1, 1, At, B1); PG8_BAR; PG8_SCHED;
        }
        if (wr == 0) PG8_BAR;
        if constexpr (FP8) asm volatile("s_nop 15\n\ts_nop 15\n\ts_nop 15\n\ts_nop 15\n\ts_nop 15\n\ts_nop 15" ::: "memory");
        E(acc, cur, wr, wc, fr, fq);
        if (!has_next) break;
#pragma unroll
        for (int a = 0; a < 2; ++a)
#pragma unroll
            for (int b = 0; b < 2; ++b)
#pragma unroll
                for (int m = 0; m < 4; ++m)
#pragma unroll
                    for (int n = 0; n < 2; ++n) acc[a][b][m][n] = (f32x4){0.f, 0.f, 0.f, 0.f};
        cur = nxt; cA = nA; cB = nB; ++ui;
        if constexpr (Sched::VARROW) {
#pragma unroll
            for (int h = 0; h < 2; ++h)
#pragma unroll
                for (int i = 0; i < 2; ++i) vC[h][i] = vN[h][i]; }
        if (wr == 1) PG8_BAR;
    }
    PG8_WAIT_V(0);
    PG8_BAR;
#undef PG8_SA
#undef PG8_SB
#undef PG8_STAGE
#undef PG8_LDA
#undef PG8_LDB
#undef PG8_MMA
#undef PG8_LD8
#undef PG8_WAIT_V
#undef PG8_WAIT_L
#undef PG8_BAR
#undef PG8_SCHED
}

struct SchedDense {
    static constexpr bool VARROW = false;
    const void* A; int lda; const void* Bt; int ldb; int ntk; int nM, nN, G, c; int esz; int wscale;
    __device__ __forceinline__ bool next(int i, Unit& u) const { const int L = i * G + c; if (L >= nM * nN) return false; static_tile(L, nM, nN, u.pm, u.pn); u.s = 0; u.x = 0; return true; }
    __device__ __forceinline__ int nt(const Unit&) const { return ntk; }
    __device__ __forceinline__ const char* aptr(const Unit& u) const { return (const char*)A + (size_t)u.pm * BM * lda * esz; }
    __device__ __forceinline__ unsigned arow(const Unit&, int r) const { return (unsigned)(r * lda * esz); }
    __device__ __forceinline__ const char* bptr(const Unit& u) const { return (const char*)Bt + (size_t)u.pn * BM * ldb * esz; }
};
struct SchedDenseRange : SchedDense {
    int base, cnt;
    __device__ __forceinline__ bool next(int i, Unit& u) const { if (i >= cnt) return false; static_tile(base + i, nM, nN, u.pm, u.pn); u.s = 0; u.x = 0; return true; }
};
struct SchedStride : SchedDense {
    int first, stride;
    __device__ __forceinline__ bool next(int i, Unit& u) const { const int L = first + i * stride; if (first < 0 || L >= nM * nN) return false; u.pm = L / nN; u.pn = L % nN; u.s = 0; u.x = 0; return true; }
};
struct SchedPair {
    static constexpr bool VARROW = true;
    const bf16* A0; const bf16* A1; int lda0, lda1; const bf16* B0; const bf16* B1; int ldb; int nt0, nt1; int nM, nN, G, c;
    __device__ __forceinline__ bool next(int i, Unit& u) const { const int L = (i >> 1) * G + c; if (L >= nM * nN) return false; static_tile(L, nM, nN, u.pm, u.pn); u.s = i & 1; u.x = 0; return true; }
    __device__ __forceinline__ int nt(const Unit& u) const { return u.s ? nt1 : nt0; }
    __device__ __forceinline__ const char* aptr(const Unit& u) const { return u.s ? (const char*)A1 + (size_t)u.pm * BM * lda1 * 2 : (const char*)A0 + (size_t)u.pm * BM * lda0 * 2; }
    __device__ __forceinline__ unsigned arow(const Unit& u, int r) const { return (unsigned)(r * (u.s ? lda1 : lda0) * 2); }
    __device__ __forceinline__ const char* bptr(const Unit& u) const { return (const char*)(u.s ? B1 : B0) + (size_t)u.pn * BM * ldb * 2; }
};
struct SchedLora {
    static constexpr bool VARROW = false;
    const bf16* A; const bf16* Bt; int pn0, npn; int G, c;
    int ldb;
    __device__ __forceinline__ bool next(int i, Unit& u) const { const int L = i * G + c; if (L >= 64 * npn) return false; u.pm = L / npn; u.pn = pn0 + L % npn; u.s = 0; u.x = 0; return true; }
    __device__ __forceinline__ int nt(const Unit&) const { return 4; }
    __device__ __forceinline__ const char* aptr(const Unit& u) const { return (const char*)A + (size_t)u.pm * BM * 512 * 2 + (u.pn >= 16 ? 512 : 0); }
    __device__ __forceinline__ unsigned arow(const Unit&, int r) const { return (unsigned)(r * 1024); }
    __device__ __forceinline__ const char* bptr(const Unit& u) const { return (const char*)Bt + (size_t)u.pn * BM * 256 * 2; }
};
struct SchedMoeUp {
    static constexpr bool VARROW = true;
    const unsigned char* U; const unsigned char* Wup; const int* slot_tok; const int* misc; int G, c; int ldb; int wscale;
    __device__ __forceinline__ bool next(int i, Unit& u) const { const int L = i * G + c; const int nt_ = misc[MI_NT]; if (L >= nt_ * 4) return false; u.pm = L >> 2; u.pn = L & 3; u.x = misc[MI_TILE_E + u.pm]; u.s = misc[MI_TILE_R0 + u.pm]; return true; }
    __device__ __forceinline__ int nt(const Unit&) const { return 16; }
    __device__ __forceinline__ const char* aptr(const Unit&) const { return (const char*)U; }
    __device__ __forceinline__ unsigned arow(const Unit& u, int r) const { return (unsigned)slot_tok[u.s + r] * 2048u; }
    __device__ __forceinline__ const char* bptr(const Unit& u) const { return (const char*)Wup + ((size_t)u.x * 1024 + (size_t)u.pn * 256) * 2048; }
};
struct SchedMoeDown {
    static constexpr bool VARROW = false;
    const unsigned char* H; const unsigned char* Wdn; const int* misc; int G, c; int ldb; int wscale;
    __device__ __forceinline__ bool next(int i, Unit& u) const { const int L = i * G + c; const int nt_ = misc[MI_NT]; if (L >= nt_ * 8) return false; u.pm = L >> 3; u.pn = L & 7; u.x = misc[MI_TILE_E + u.pm]; u.s = misc[MI_TILE_R0 + u.pm]; return true; }
    __device__ __forceinline__ int nt(const Unit&) const { return 4; }
    __device__ __forceinline__ const char* aptr(const Unit& u) const { return (const char*)H + (size_t)u.s * 512; }
    __device__ __forceinline__ unsigned arow(const Unit&, int r) const { return (unsigned)(r * 512); }
    __device__ __forceinline__ const char* bptr(const Unit& u) const { return (const char*)Wdn + ((size_t)u.x * 2048 + (size_t)u.pn * 256) * 512; }
};

#define EPI_ROWS_BEGIN _Pragma("unroll") for (int ai = 0; ai < 2; ++ai) _Pragma("unroll") for (int m = 0; m < 4; ++m) { const int rl = ai * HALF + wr * 64 + m * 16 + fr;
#define EPI_ROWS_END }
#define EPI_HROWS_BEGIN _Pragma("unroll") for (int m = 0; m < 4; ++m) { const int rl = ai * HALF + wr * 64 + m * 16 + fr;
struct EpiZ {
    bf16* Z; unsigned* QKN;
    __device__ __forceinline__ void operator()(const f32x4 (&acc)[2][2][4][2], const Unit& u, int wr, int wc, int fr, int fq) const {
        const int cl = u.pn * BM + wc * 32 + 8 * fq;
        EPI_ROWS_BEGIN
            bf16* rowp = Z + ((size_t)u.pm * BM + rl) * ZLD + cl;
#pragma unroll
            for (int bj = 0; bj < 2; ++bj) { const f32x4 v0 = acc[ai][bj][m][0], v1 = acc[ai][bj][m][1];
                u32x4 w; w.x = cvt_pk_bf16_hz(v0[0], v0[1]); w.y = cvt_pk_bf16_hz(v0[2], v0[3]); w.z = cvt_pk_bf16_hz(v1[0], v1[1]); w.w = cvt_pk_bf16_hz(v1[2], v1[3]);
                *(u32x4*)(rowp + bj * HALF) = w; }
        EPI_ROWS_END
        if (u.pn < 8) {
#pragma unroll
            for (int bj = 0; bj < 2; ++bj) { float nm = 0.f;
                EPI_ROWS_BEGIN
                    const f32x4 v0 = acc[ai][bj][m][0], v1 = acc[ai][bj][m][1];
                    float ss = v0[0] * v0[0] + v0[1] * v0[1] + v0[2] * v0[2] + v0[3] * v0[3] + v1[0] * v1[0] + v1[1] * v1[1] + v1[2] * v1[2] + v1[3] * v1[3];
                    ss += __shfl_xor(ss, 16); ss += __shfl_xor(ss, 32); nm = fmaxf(nm, ss); (void)rl;
                EPI_ROWS_END
                nm = row16_max(nm);
                if (fr == 0 && fq == 0) atomicMax(QKN + (u.pm >> 3) * 64 + ((u.pn * BM + wc * 32 + bj * HALF) >> 5), __float_as_uint(nm)); }
        }
    }
};
__device__ __forceinline__ unsigned pk4_u8(float a, float b, float c, float d) {
    return (unsigned)(a * 255.0f + 0.5f) | ((unsigned)(b * 255.0f + 0.5f) << 8) | ((unsigned)(c * 255.0f + 0.5f) << 16) | ((unsigned)(d * 255.0f + 0.5f) << 24); }
struct EpiGate {
    unsigned char* GT;
    __device__ __forceinline__ void operator()(const f32x4 (&acc)[2][2][4][2], const Unit& u, int wr, int wc, int fr, int fq) const {
        const int cl = u.pn * BM + wc * 32 + 8 * fq;
        EPI_ROWS_BEGIN
            unsigned char* rowp = GT + ((size_t)u.pm * BM + rl) * GLD + cl;
#pragma unroll
            for (int bj = 0; bj < 2; ++bj) { f32x4 v0 = acc[ai][bj][m][0], v1 = acc[ai][bj][m][1];
#pragma unroll
                for (int j = 0; j < 4; ++j) { v0[j] = sigm(v0[j]); v1[j] = sigm(v1[j]); }
                u32x2 w; w.x = pk4_u8(v0[0], v0[1], v0[2], v0[3]); w.y = pk4_u8(v1[0], v1[1], v1[2], v1[3]);
                *(u32x2*)(rowp + bj * HALF) = w; }
        EPI_ROWS_END
    }
};
struct EpiLoraW {
    bf16* DD; const float* w0;
    __device__ __forceinline__ void operator()(const f32x4 (&acc)[2][2][4][2], const Unit& u, int wr, int wc, int fr, int fq) const {
        const int d = (u.pn >> 2) & 1, cb = (u.pn & 3) * BM + wc * 32 + 8 * fq;
#pragma unroll
        for (int bj = 0; bj < 2; ++bj) { const int c = cb + bj * HALF;
            const f32x4 b0 = *(const f32x4*)(w0 + d * 1024 + c), b1 = *(const f32x4*)(w0 + d * 1024 + c + 4);
            EPI_ROWS_BEGIN
                const size_t row = (size_t)u.pm * BM + rl; f32x4 v0 = acc[ai][bj][m][0], v1 = acc[ai][bj][m][1];
#pragma unroll
                for (int j = 0; j < 4; ++j) { v0[j] = 1.0f - ex2(-0.60653065971f * LOG2E * sigm(v0[j] + b0[j])); v1[j] = 1.0f - ex2(-0.60653065971f * LOG2E * sigm(v1[j] + b1[j])); }
                u32x4 w; w.x = cvt_pk_bf16(v0[0], v0[1]); w.y = cvt_pk_bf16(v0[2], v0[3]); w.z = cvt_pk_bf16(v1[0], v1[1]); w.w = cvt_pk_bf16(v1[2], v1[3]);
                *(u32x4*)(DD + ((size_t)d * NTOK + row) * 1024 + c) = w;
            EPI_ROWS_END }
    }
};
struct EpiLoraA {
    bf16* KT; bf16* BV; const bf16* KS; const bf16* KK; const float* a0; const float* k_a;
    __device__ __forceinline__ void operator()(const f32x4 (&acc)[2][2][4][2], const Unit& u, int wr, int wc, int fr, int fq) const {
        const int d = (u.pn >> 2) & 1, cb = (u.pn & 3) * BM + wc * 32 + 8 * fq;
#pragma unroll
        for (int bj = 0; bj < 2; ++bj) { const int c = cb + bj * HALF;
            const f32x4 b0 = *(const f32x4*)(a0 + d * 1024 + c), b1 = *(const f32x4*)(a0 + d * 1024 + c + 4);
            const f32x4 ka0 = *(const f32x4*)(k_a + c), ka1 = *(const f32x4*)(k_a + c + 4);
#pragma unroll
            for (int ai = 0; ai < 2; ++ai) {
            u32x4 ksw[4], kkw[4];
            EPI_HROWS_BEGIN
                const size_t row = (size_t)u.pm * BM + rl; ksw[m] = *(const u32x4*)(KS + row * 1024 + c); kkw[m] = *(const u32x4*)(KK + row * 1024 + c);
            EPI_ROWS_END
            EPI_HROWS_BEGIN
                const size_t row = (size_t)u.pm * BM + rl; const f32x4 v0 = acc[ai][bj][m][0], v1 = acc[ai][bj][m][1];
                float kv[8], kkv[8], kt[8], bb[8];
                unpack8(ksw[m], kv); unpack8(kkw[m], kkv);
#pragma unroll
                for (int j = 0; j < 4; ++j) { const float a_0 = sigm(v0[j] + b0[j]), a_1 = sigm(v1[j] + b1[j]);
                    kt[j] = kv[j] * (1.0f + (a_0 - 1.0f) * ka0[j]); kt[4 + j] = kv[4 + j] * (1.0f + (a_1 - 1.0f) * ka1[j]);
                    bb[j] = kkv[j] * a_0; bb[4 + j] = kkv[4 + j] * a_1; }
                *(u32x4*)(KT + ((size_t)d * NTOK + row) * 1024 + c) = pack8(kt); *(u32x4*)(BV + ((size_t)d * NTOK + row) * 1024 + c) = pack8(bb);
            EPI_ROWS_END } }
    }
};
struct EpiLoraG {
    bf16* GG;
    __device__ __forceinline__ void operator()(const f32x4 (&acc)[2][2][4][2], const Unit& u, int wr, int wc, int fr, int fq) const {
        const int cb = (u.pn & 3) * BM + wc * 32 + 8 * fq;
        EPI_ROWS_BEGIN
            const size_t row = (size_t)u.pm * BM + rl;
#pragma unroll
            for (int bj = 0; bj < 2; ++bj) { const int c = cb + bj * HALF; const f32x4 v0 = acc[ai][bj][m][0], v1 = acc[ai][bj][m][1];
                u32x4 w; w.x = cvt_pk_bf16_hz(v0[0], v0[1]); w.y = cvt_pk_bf16_hz(v0[2], v0[3]); w.z = cvt_pk_bf16_hz(v1[0], v1[1]); w.w = cvt_pk_bf16_hz(v1[2], v1[3]);
                *(u32x4*)(GG + row * 1024 + c) = w; }
        EPI_ROWS_END
    }
};
struct EpiMerge {
    bf16* M; const unsigned char* GT;
    __device__ __forceinline__ void operator()(const f32x4 (&acc)[2][2][4][2], const Unit& u, int wr, int wc, int fr, int fq) const {
        const int cb = u.pn * BM + wc * 32 + 8 * fq;
#pragma unroll
        for (int ai = 0; ai < 2; ++ai) {
        u32x2 gws[1][4][2]; u32x4 pws[1][4][2];
        EPI_HROWS_BEGIN
            const size_t row = (size_t)u.pm * BM + rl;
#pragma unroll
            for (int bj = 0; bj < 2; ++bj) { const int c = cb + bj * HALF; gws[0][m][bj] = *(const u32x2*)(GT + row * GLD + u.s * 2048 + c);
                pws[0][m][bj] = u.s ? *(const u32x4*)(M + row * 2048 + c) : (u32x4){0u, 0u, 0u, 0u}; }
        EPI_ROWS_END
        EPI_HROWS_BEGIN
            const size_t row = (size_t)u.pm * BM + rl;
#pragma unroll
            for (int bj = 0; bj < 2; ++bj) { const int c = cb + bj * HALF; const f32x4 v0 = acc[ai][bj][m][0], v1 = acc[ai][bj][m][1];
                const u32x2 gw = gws[0][m][bj]; constexpr float q = 1.0f / 255.0f;
                float o[8] = {v0[0] * ((float)(gw.x & 0xffu) * q), v0[1] * ((float)((gw.x >> 8) & 0xffu) * q), v0[2] * ((float)((gw.x >> 16) & 0xffu) * q), v0[3] * ((float)(gw.x >> 24) * q),
                              v1[0] * ((float)(gw.y & 0xffu) * q), v1[1] * ((float)((gw.y >> 8) & 0xffu) * q), v1[2] * ((float)((gw.y >> 16) & 0xffu) * q), v1[3] * ((float)(gw.y >> 24) * q)};
                bf16* dst = M + row * 2048 + c;
                { const u32x4 pw = pws[0][m][bj];
                    o[0] += bflo(pw.x); o[1] += bfhi(pw.x); o[2] += bflo(pw.y); o[3] += bfhi(pw.y); o[4] += bflo(pw.z); o[5] += bfhi(pw.z); o[6] += bflo(pw.w); o[7] += bfhi(pw.w); }
                u32x4 w; w.x = cvt_pk_bf16(o[0], o[1]); w.y = cvt_pk_bf16(o[2], o[3]); w.z = cvt_pk_bf16(o[4], o[5]); w.w = cvt_pk_bf16(o[6], o[7]);
                *(u32x4*)dst = w; }
        EPI_ROWS_END
        }
    }
};
struct EpiResF32 {
    bf16* O; const float* R;
    __device__ __forceinline__ void operator()(const f32x4 (&acc)[2][2][4][2], const Unit& u, int wr, int wc, int fr, int fq) const {
        const int cb = u.pn * BM + wc * 32 + 8 * fq;
#pragma unroll
        for (int ai = 0; ai < 2; ++ai) {
#pragma unroll
          for (int bj = 0; bj < 2; ++bj) {
            f32x4 xr[4][2][2];
#pragma unroll
            for (int m = 0; m < 4; ++m)
                { const size_t o = ((size_t)u.pm * BM + ai * HALF + wr * 64 + m * 16 + fr) * 2048 + cb + bj * HALF; xr[m][bj][0] = *(const f32x4*)(R + o); xr[m][bj][1] = *(const f32x4*)(R + o + 4); }
#pragma unroll
            for (int m = 0; m < 4; ++m)
                { const size_t o = ((size_t)u.pm * BM + ai * HALF + wr * 64 + m * 16 + fr) * 2048 + cb + bj * HALF;
                    const f32x4 h0 = xr[m][bj][0] + acc[ai][bj][m][0], h1 = xr[m][bj][1] + acc[ai][bj][m][1];
                    u32x4 w; w.x = cvt_pk_bf16_hz(h0[0], h0[1]); w.y = cvt_pk_bf16_hz(h0[2], h0[3]); w.z = cvt_pk_bf16_hz(h1[0], h1[1]); w.w = cvt_pk_bf16_hz(h1[2], h1[3]);
                    *(u32x4*)(O + o) = w; }
          }
        }
    }
};
struct EpiUp {
    unsigned char* H;
    __device__ __forceinline__ void operator()(const f32x4 (&acc)[2][2][4][2], const Unit& u, int wr, int wc, int fr, int fq) const {
        const int c = u.pn * HALF + wc * 32 + 8 * fq;
        EPI_ROWS_BEGIN
            const size_t row = (size_t)u.s + rl; float o[8];
#pragma unroll
            for (int n = 0; n < 2; ++n)
#pragma unroll
                for (int j = 0; j < 4; ++j) { const float g = acc[ai][0][m][n][j]; o[4 * n + j] = g * sigm(g) * acc[ai][1][m][n][j]; }
            u32x2 w; w.x = pk4_fp8(o[0], o[1], o[2], o[3]); w.y = pk4_fp8(o[4], o[5], o[6], o[7]);
            *(u32x2*)(H + row * EFF + c) = w;
        EPI_ROWS_END
    }
};
struct EpiDown {
    unsigned char* Y; const int* slot_dst; const float* slot_g;
    __device__ __forceinline__ void operator()(const f32x4 (&acc)[2][2][4][2], const Unit& u, int wr, int wc, int fr, int fq) const {
        const int cb = u.pn * BM + wc * 32 + 8 * fq;
        int dsts[2][4]; float gsc[2][4];
        EPI_ROWS_BEGIN
            dsts[ai][m] = slot_dst[u.s + rl]; gsc[ai][m] = slot_g[u.s + rl];
        EPI_ROWS_END
        EPI_ROWS_BEGIN
            const int dst = dsts[ai][m]; const float g = gsc[ai][m] * 16.0f; (void)rl;
            if (dst >= 0) {
#pragma unroll
                for (int bj = 0; bj < 2; ++bj) { const f32x4 v0 = acc[ai][bj][m][0] * g, v1 = acc[ai][bj][m][1] * g;
                    u32x2 w; w.x = pk4_fp8(v0[0], v0[1], v0[2], v0[3]); w.y = pk4_fp8(v1[0], v1[1], v1[2], v1[3]);
                    *(u32x2*)(Y + (size_t)dst * 2048 + cb + bj * HALF) = w; } }
        EPI_ROWS_END
    }
};
struct EpiP {
    unsigned char* P;
    __device__ __forceinline__ void operator()(const f32x4 (&acc)[2][2][4][2], const Unit& u, int wr, int wc, int fr, int fq) const {
        const int cb = u.pn * BM + wc * 32 + 8 * fq;
        EPI_ROWS_BEGIN
            const size_t row = (size_t)u.pm * BM + rl;
#pragma unroll
            for (int bj = 0; bj < 2; ++bj) { const size_t o = row * 2048 + cb + bj * HALF; const f32x4 v0 = acc[ai][bj][m][0], v1 = acc[ai][bj][m][1];
                u32x2 w; w.x = pk4_fp8(v0[0], v0[1], v0[2], v0[3]); w.y = pk4_fp8(v1[0], v1[1], v1[2], v1[3]); *(u32x2*)(P + o) = w; }
        EPI_ROWS_END
    }
};
struct EpiPleG {
    const unsigned char* P; bf16* O;
    __device__ __forceinline__ void operator()(const f32x4 (&acc)[2][2][4][2], const Unit& u, int wr, int wc, int fr0, int fq) const {
        int fr = fr0; asm volatile("" : "+v"(fr));
        const int cb = u.pn * BM + wc * 32 + 8 * fq;
#pragma unroll
        for (int ai = 0; ai < 2; ++ai)
#pragma unroll
          for (int bj = 0; bj < 2; ++bj) {
            u32x2 pws[4]; u32x4 hws[4];
            EPI_HROWS_BEGIN
                const size_t o = ((size_t)u.pm * BM + rl) * 2048 + cb + bj * HALF; pws[m] = *(const u32x2*)(P + o); hws[m] = *(const u32x4*)(O + o);
            EPI_ROWS_END
            EPI_HROWS_BEGIN
                const size_t o = ((size_t)u.pm * BM + rl) * 2048 + cb + bj * HALF; const f32x4 v0 = acc[ai][bj][m][0], v1 = acc[ai][bj][m][1];
                const u32x2 pw = pws[m]; const u32x4 hw = hws[m]; f32x4 h0 = {bflo(hw.x), bfhi(hw.x), bflo(hw.y), bfhi(hw.y)}, h1 = {bflo(hw.z), bfhi(hw.z), bflo(hw.w), bfhi(hw.w)};
                const f32x2 p0 = __builtin_amdgcn_cvt_pk_f32_fp8((int)pw.x, false), p1 = __builtin_amdgcn_cvt_pk_f32_fp8((int)pw.x, true), p2 = __builtin_amdgcn_cvt_pk_f32_fp8((int)pw.y, false), p3 = __builtin_amdgcn_cvt_pk_f32_fp8((int)pw.y, true);
                h0[0] += sigm(v0[0]) * p0.x; h0[1] += sigm(v0[1]) * p0.y; h0[2] += sigm(v0[2]) * p1.x; h0[3] += sigm(v0[3]) * p1.y;
                h1[0] += sigm(v1[0]) * p2.x; h1[1] += sigm(v1[1]) * p2.y; h1[2] += sigm(v1[2]) * p3.x; h1[3] += sigm(v1[3]) * p3.y;
                u32x4 w; w.x = cvt_pk_bf16_hz(h0[0], h0[1]); w.y = cvt_pk_bf16_hz(h0[2], h0[3]); w.z = cvt_pk_bf16_hz(h1[0], h1[1]); w.w = cvt_pk_bf16_hz(h1[2], h1[3]);
                *(u32x4*)(O + o) = w;
            EPI_ROWS_END
          }
    }
};
}

struct Frame {
    LAS unsigned char* lds; unsigned char* ws; const float* const* in; float* out;
    int tid, lane, wave, vcu, G, gw, NGW;
};
struct Args { const float* in[38]; float* out; unsigned char* ws; int ph_lo, ph_hi; };

__device__ __forceinline__ void tr_item(const float* W, int ldw, int k0, int n0, bf16* WT, size_t rowbase, int ldt, int kc0, LAS float* scr, int lane) {
    float v[32];
#pragma unroll
    for (int i = 0; i < 32; ++i) v[i] = W[(size_t)(k0 + 2 * i + (lane >> 5)) * ldw + n0 + (lane & 31)];
#pragma unroll
    for (int i = 0; i < 32; ++i) scr[(2 * i + (lane >> 5)) * 33 + (lane & 31)] = v[i];
    LDS_WAIT(); asm volatile("" ::: "memory");
    const int c = lane & 7;
#pragma unroll
    for (int j = 0; j < 4; ++j) { const int n = (lane >> 3) + 8 * j; const LAS float* s = scr + (8 * c) * 33 + n;
        u32x4 o; o.x = cvt_pk_bf16(s[0 * 33], s[1 * 33]); o.y = cvt_pk_bf16(s[2 * 33], s[3 * 33]); o.z = cvt_pk_bf16(s[4 * 33], s[5 * 33]); o.w = cvt_pk_bf16(s[6 * 33], s[7 * 33]);
        *(u32x4*)(WT + (rowbase + n) * ldt + kc0 + 8 * c) = o; }
    LDS_WAIT(); asm volatile("" ::: "memory");
}
__device__ __forceinline__ void tr_mat(const float* W, int K, int N, bf16* WT, size_t rowoff, int ldt, int kc0, int it, LAS float* scr, int lane) {
    const int nblk = N / 32, kb = it / nblk, nb = it % nblk;
    tr_item(W, N, 64 * kb, 32 * nb, WT, rowoff + 32 * nb, ldt, kc0 + 64 * kb, scr, lane);
}

__device__ __forceinline__ void tr_item8(const float* W, int ldw, int k0, int n0, unsigned char* WT, size_t rowbase, int ldt, int kc0, float scale, LAS float* scr, int lane) {
    float v[32];
#pragma unroll
    for (int i = 0; i < 32; ++i) v[i] = W[(size_t)(k0 + 2 * i + (lane >> 5)) * ldw + n0 + (lane & 31)];
#pragma unroll
    for (int i = 0; i < 32; ++i) scr[(2 * i + (lane >> 5)) * 33 + (lane & 31)] = v[i] * scale;
    LDS_WAIT(); asm volatile("" ::: "memory");
    const int c = lane & 3;
#pragma unroll
    for (int j = 0; j < 2; ++j) { const int n = (lane >> 2) + 16 * j; const LAS float* s = scr + (16 * c) * 33 + n;
        u32x4 o; o.x = pk4_fp8(s[0 * 33], s[1 * 33], s[2 * 33], s[3 * 33]); o.y = pk4_fp8(s[4 * 33], s[5 * 33], s[6 * 33], s[7 * 33]);
        o.z = pk4_fp8(s[8 * 33], s[9 * 33], s[10 * 33], s[11 * 33]); o.w = pk4_fp8(s[12 * 33], s[13 * 33], s[14 * 33], s[15 * 33]);
        *(u32x4*)(WT + (rowbase + n) * ldt + kc0 + 16 * c) = o; }
    LDS_WAIT(); asm volatile("" ::: "memory");
}
struct ConvItem { const float* src; unsigned char* dst; int ldw, ldt; float scale; };
__device__ __forceinline__ ConvItem conv_item(const float* const* in, unsigned char* ws, int it, int lane) {
    ConvItem c; const int e = it / 1536, r2 = it % 1536, which = r2 >> 9, q = r2 & 511;
    if (which < 2) { const float* src = e < 64 ? in[28 + which] + (size_t)e * 2048 * 512 : in[31 + which];
        const int kb = q >> 4, nb = q & 15, n0 = 32 * nb;
        c.src = src + (size_t)(64 * kb) * 512 + n0; c.ldw = 512; c.dst = ws + WS_WUP + ((size_t)e * 1024 + (n0 >> 7) * 256 + which * 128 + (n0 & 127)) * 2048 + 64 * kb; c.ldt = 2048; c.scale = 64.0f; }
    else { const float* src = e < 64 ? in[30] + (size_t)e * 512 * 2048 : in[33];
        const int kb = q >> 6, nb = q & 63;
        c.src = src + (size_t)(64 * kb) * 2048 + 32 * nb; c.ldw = 2048; c.dst = ws + WS_WDN + ((size_t)e * 2048 + 32 * nb) * 512 + 64 * kb; c.ldt = 512; c.scale = 32.0f; }
    return c;
}
__device__ __forceinline__ void conv_load(const ConvItem& c, float (&v)[32], int lane) {
#pragma unroll
    for (int i = 0; i < 32; ++i) v[i] = c.src[(size_t)(2 * i + (lane >> 5)) * c.ldw + (lane & 31)];
}
__device__ __forceinline__ void conv_store(const ConvItem& c, const float (&v)[32], LAS float* scr, int lane) {
#pragma unroll
    for (int i = 0; i < 32; ++i) scr[(2 * i + (lane >> 5)) * 33 + (lane & 31)] = v[i] * c.scale;
    LDS_WAIT(); asm volatile("" ::: "memory");
    const int cc = lane & 3;
#pragma unroll
    for (int j = 0; j < 2; ++j) { const int n = (lane >> 2) + 16 * j; const LAS float* s = scr + (16 * cc) * 33 + n;
        u32x4 o; o.x = pk4_fp8(s[0 * 33], s[1 * 33], s[2 * 33], s[3 * 33]); o.y = pk4_fp8(s[4 * 33], s[5 * 33], s[6 * 33], s[7 * 33]);
        o.z = pk4_fp8(s[8 * 33], s[9 * 33], s[10 * 33], s[11 * 33]); o.w = pk4_fp8(s[12 * 33], s[13 * 33], s[14 * 33], s[15 * 33]);
        *(u32x4*)(c.dst + (size_t)n * c.ldt + 16 * cc) = o; }
    LDS_WAIT(); asm volatile("" ::: "memory");
}
__device__ __forceinline__ void expert_conv_pair(const float* const* in, unsigned char* ws, int it0, int it1, LAS float* scr, int lane) {
    constexpr int NIT = 65 * 1536;
    if (it0 >= NIT) return;
    const ConvItem c0 = conv_item(in, ws, it0, lane); float v0[32]; conv_load(c0, v0, lane);
    if (it1 < NIT) { const ConvItem c1 = conv_item(in, ws, it1, lane); float v1[32]; conv_load(c1, v1, lane); conv_store(c0, v0, scr, lane); conv_store(c1, v1, scr, lane); }
    else conv_store(c0, v0, scr, lane);
}
struct ConvQ { const float* src; unsigned char* dst; int ldw, ldt; float scale; };
__device__ __forceinline__ ConvQ conv_quad_item(const float* const* in, unsigned char* ws, int it, int lane) {
    ConvQ c; const int e = it / 768, r2 = it % 768, which = r2 >> 8, q = r2 & 255, r = lane >> 5, cc = lane & 31;
    if (which < 2) { const float* W = e < 64 ? in[28 + which] + (size_t)e * 2048 * 512 : in[31 + which];
        const int kb = q >> 2, nb = q & 3; c.ldw = 512; c.ldt = 2048; c.scale = 64.0f;
        c.src = W + (size_t)(32 * kb + 16 * r) * 512 + 128 * nb + 4 * cc;
        c.dst = ws + WS_WUP + ((size_t)e * 1024 + nb * 256 + which * 128 + 4 * cc) * 2048 + 32 * kb + 16 * r; }
    else { const float* W = e < 64 ? in[30] + (size_t)e * 512 * 2048 : in[33];
        const int kb = q >> 4, nb = q & 15; c.ldw = 2048; c.ldt = 512; c.scale = 32.0f;
        c.src = W + (size_t)(32 * kb + 16 * r) * 2048 + 128 * nb + 4 * cc;
        c.dst = ws + WS_WDN + ((size_t)e * 2048 + 128 * nb + 4 * cc) * 512 + 32 * kb + 16 * r; }
    return c;
}
__device__ __forceinline__ void conv_quad_load(const ConvQ& c, f32x4 (&v)[16]) {
#pragma unroll
    for (int i = 0; i < 16; ++i) v[i] = *(const f32x4*)(c.src + (size_t)i * c.ldw);
}
__device__ __forceinline__ void conv_quad_store(const ConvQ& c, const f32x4 (&v)[16]) {
#pragma unroll
    for (int e4 = 0; e4 < 4; ++e4) { unsigned w[4];
#pragma unroll
        for (int g = 0; g < 4; ++g) w[g] = pk4_fp8(v[4 * g][e4] * c.scale, v[4 * g + 1][e4] * c.scale, v[4 * g + 2][e4] * c.scale, v[4 * g + 3][e4] * c.scale);
        *(u32x4*)(c.dst + (size_t)e4 * c.ldt) = (u32x4){w[0], w[1], w[2], w[3]}; }
}
__device__ __forceinline__ void rms_row_bf16(const float* xrow, const f32x4 (&gg8)[8], bf16* orow, unsigned char* orow8, int lane) {
    const f32x4* xr = (const f32x4*)xrow + lane;
    f32x4 v[8]; float s = 0.f;
#pragma unroll
    for (int j = 0; j < 8; ++j) { v[j] = xr[64 * j]; s += (v[j].x * v[j].x + v[j].y * v[j].y) + (v[j].z * v[j].z + v[j].w * v[j].w); }
    const float rstd = __builtin_amdgcn_rsqf(wave_sum(s) * (1.f / DM) + RMS_EPS);
    u32x2* o8 = (u32x2*)orow + lane; unsigned* o4 = (unsigned*)orow8 + lane;
#pragma unroll
    for (int j = 0; j < 8; ++j) { const f32x4 gg = gg8[j]; const float a = v[j].x * rstd * gg.x, b = v[j].y * rstd * gg.y, c = v[j].z * rstd * gg.z, d = v[j].w * rstd * gg.w;
        u32x2 w; w.x = cvt_pk_bf16(a, b); w.y = cvt_pk_bf16(c, d); o8[64 * j] = w; o4[64 * j] = pk4_fp8(a, b, c, d); }
}

__device__ __forceinline__ void p0_prologue(Frame& F) {
    LAS float* scr = (LAS float*)(F.lds + F.wave * 16384);
    unsigned char* ws = F.ws;
    bf16* W1 = (bf16*)(ws + WS_W1); bf16* WBR = (bf16*)(ws + WS_WBR); bf16* WOUT = (bf16*)(ws + WS_WOUT); bf16* WPG = (bf16*)(ws + WS_WPG); bf16* WPP = (bf16*)(ws + WS_WPP); bf16* WL = (bf16*)(ws + WS_WL);
    constexpr int I_IN = 32 * 205, I_BG = 32 * 128, I_BR = 16 * 64, I_O = 32 * 64, I_PP = 4 * 64, I_LO = 32;
    constexpr int NIT = I_IN + I_BG + 2 * I_BR + 2 * I_O + I_PP + 4 * I_LO;
    for (int it = F.gw; it < NIT; it += F.NGW) {
        int r = it;
        if (r < I_IN) { tr_mat(F.in[3], 2048, 6560, W1, 0, 2048, 0, r, scr, F.lane); continue; } r -= I_IN;
        if (r < I_BG) { const int kb = r >> 7, nb = r & 127; tr_item8(F.in[4], 4096, 64 * kb, 32 * nb, ws + WS_W1G8, (size_t)32 * nb, 2048, 64 * kb, 64.0f, scr, F.lane); continue; } r -= I_BG;
        if (r < I_BR) { tr_mat(F.in[22], 1024, 2048, WBR, 0, 1024, 0, r, scr, F.lane); continue; } r -= I_BR;
        if (r < I_BR) { tr_mat(F.in[23], 1024, 2048, WBR, 2048, 1024, 0, r, scr, F.lane); continue; } r -= I_BR;
        if (r < I_O) { tr_mat(F.in[24], 2048, 2048, WOUT, 0, 2048, 0, r, scr, F.lane); continue; } r -= I_O;
        if (r < I_O) { const int kb = r >> 6, nb = r & 63; tr_item8(F.in[35], 2048, 64 * kb, 32 * nb, (unsigned char*)WPG, (size_t)32 * nb, 2048, 64 * kb, 64.0f, scr, F.lane); continue; } r -= I_O;
        if (r < I_PP) { tr_mat(F.in[36], 256, 2048, WPP, 0, 2048, 0, r, scr, F.lane); continue; } r -= I_PP;
        { const int which = r / I_LO, nb = r % I_LO, d = which & 1;
          const float* src = (which < 2 ? F.in[13] : F.in[15]) + (size_t)d * 64 * 1024;
          tr_item(src, 1024, 0, 32 * nb, WL, (size_t)(which < 2 ? 0 : 2048) + d * 1024 + 32 * nb, 256, (which < 2 ? 0 : 128) + d * 64, scr, F.lane); }
    }
    const int gt = F.gw * 64 + F.lane, NGT = F.NGW * 64;
    for (int i = gt; i < 160 * 1024; i += NGT) { const int k = i >> 10, n = i & 1023; WL[(size_t)(4096 + n) * 256 + k] = (bf16)(cvt_pk_bf16(F.in[16][i], 0.f) & 0xffffu); }
    for (int i = gt; i < 5120 * 32; i += NGT) { const int row = i >> 5, k8 = (i & 31) * 8;
        const int k0 = row < 2048 ? (row >> 10) * 64 : row < 4096 ? 128 + ((row - 2048) >> 10) * 64 : 0, kl = row < 4096 ? 64 : 160;
        if (k8 < k0 || k8 >= k0 + kl) *(u32x4*)(WL + (size_t)row * 256 + k8) = (u32x4){0u, 0u, 0u, 0u}; }
    for (int i = gt; i < 96 * 256; i += NGT) *(u32x4*)(W1 + (size_t)6560 * 2048 + (size_t)i * 8) = (u32x4){0u, 0u, 0u, 0u};
    { bf16* WF = (bf16*)(ws + WS_WRT); const float* g = F.in[25]; const float* wr = F.in[26];
      for (int i = gt; i < 2048 * 64; i += NGT) { const int k = i >> 6, e = i & 63; const float v = g[k] * wr[i]; const unsigned hb = cvt_pk_bf16(v, 0.f) & 0xffffu; const float vh = __builtin_bit_cast(float, hb << 16);
          const size_t o = ((size_t)((k >> 4) * 4 + (e >> 5) * 2) * 64 + ((k >> 3) & 1) * 32 + (e & 31)) * 8 + (k & 7);
          WF[o] = (bf16)hb; WF[o + 512] = (bf16)(cvt_pk_bf16(v - vh, 0.f) & 0xffffu); } }
    { u32x2* PB = (u32x2*)(ws + WS_PB); const f32x4* p = (const f32x4*)F.in[1];
      for (int i = gt; i < NTOK * 256 / 4; i += NGT) { const f32x4 v = p[i]; u32x2 w; w.x = cvt_pk_bf16(v.x, v.y); w.y = cvt_pk_bf16(v.z, v.w); PB[i] = w; } }
    bf16* U = (bf16*)(ws + WS_U);
    f32x4 gg8[8];
#pragma unroll
    for (int j = 0; j < 8; ++j) gg8[j] = ((const f32x4*)F.in[2] + F.lane)[64 * j];
    for (int m = F.gw; m < NTOK; m += F.NGW) rms_row_bf16(F.in[0] + (size_t)m * DM, gg8, U + (size_t)m * DM, ws + WS_U8E + (size_t)m * DM, F.lane);
}

__device__ __forceinline__ void shift16(const bf16* zr, bool hasp, bool hasn, int c0, const float* mp, const float* mn, float (&o)[16]) {
#pragma unroll
    for (int hh = 0; hh < 2; ++hh) {
        float z[8], zp[8], zn[8];
        unpack8(*(const u32x4*)(zr + c0 + 8 * hh), z);
        if (hasp) unpack8(*(const u32x4*)(zr - ZLD + c0 + 8 * hh), zp);
        if (hasn) unpack8(*(const u32x4*)(zr + ZLD + c0 + 8 * hh), zn);
#pragma unroll
        for (int j = 0; j < 8; ++j) { const float p = hasp ? zp[j] : 0.f, n = hasn ? zn[j] : 0.f; o[8 * hh + j] = z[j] + mp[c0 + 8 * hh + j] * (p - z[j]) + mn[c0 + 8 * hh + j] * (n - z[j]); }
    }
}
struct ShRaw { u32x4 z[2], zp[2], zn[2]; };
__device__ __forceinline__ void shift_load(const bf16* zr, bool hasp, bool hasn, int c0, ShRaw& w) {
#pragma unroll
    for (int hh = 0; hh < 2; ++hh) { w.z[hh] = *(const u32x4*)(zr + c0 + 8 * hh);
        w.zp[hh] = hasp ? *(const u32x4*)(zr - ZLD + c0 + 8 * hh) : (u32x4){0u, 0u, 0u, 0u}; w.zn[hh] = hasn ? *(const u32x4*)(zr + ZLD + c0 + 8 * hh) : (u32x4){0u, 0u, 0u, 0u}; }
}
__device__ __forceinline__ void shift_comp(const ShRaw& w, int c0, const LAS float* mp, const LAS float* mn, float (&o)[16]) {
#pragma unroll
    for (int hh = 0; hh < 2; ++hh) { float z[8], zp[8], zn[8]; unpack8(w.z[hh], z); unpack8(w.zp[hh], zp); unpack8(w.zn[hh], zn);
        const f32x4 p0 = *(const LAS f32x4*)(mp + c0 + 8 * hh), p1 = *(const LAS f32x4*)(mp + c0 + 8 * hh + 4), n0 = *(const LAS f32x4*)(mn + c0 + 8 * hh), n1 = *(const LAS f32x4*)(mn + c0 + 8 * hh + 4);
#pragma unroll
        for (int j = 0; j < 4; ++j) { o[8 * hh + j] = z[j] + p0[j] * (zp[j] - z[j]) + n0[j] * (zn[j] - z[j]); o[8 * hh + 4 + j] = z[4 + j] + p1[j] * (zp[4 + j] - z[4 + j]) + n1[j] * (zn[4 + j] - z[4 + j]); } }
}
__device__ __forceinline__ void store16(bf16* dst, const float (&o)[16]) {
    float a[8], b[8];
#pragma unroll
    for (int j = 0; j < 8; ++j) { a[j] = o[j]; b[j] = o[8 + j]; }
    *(u32x4*)dst = pack8(a); *(u32x4*)(dst + 8) = pack8(b);
}
__device__ __forceinline__ void p2_shift(Frame& F) {
    unsigned char* ws = F.ws;
    const bf16* Z = (const bf16*)(ws + WS_Z); bf16* R = (bf16*)(ws + WS_R); bf16* KS = (bf16*)(ws + WS_KS); bf16* V = (bf16*)(ws + WS_V); bf16* KK = (bf16*)(ws + WS_KK); bf16* AP = (bf16*)(ws + WS_AP);
    const int lane = F.lane;
    LAS float* mp = (LAS float*)F.lds; LAS float* mn = mp + 3584; LAS float* k_k = mn + 3584;
    for (int i = F.tid; i < 3488; i += 512) { mp[i] = F.in[10][i]; mn[i] = F.in[11][i]; }
    for (int i = F.tid; i < 1024; i += 512) k_k[i] = F.in[17][i];
    __syncthreads();
    for (int t = F.gw; t < NTOK; t += F.NGW) {
        const int tt = t & (SEQ - 1); const bool hasp = tt != 0, hasn = tt != SEQ - 1;
        const bf16* zr = Z + (size_t)t * ZLD + ZR;
        ShRaw wR, wV, wK, wL; float o[16], oL[16];
        shift_load(zr, hasp, hasn, 16 * lane, wR); shift_load(zr, hasp, hasn, 2048 + 16 * lane, wV); shift_load(zr, hasp, hasn, 1024 + 16 * lane, wK);
        if (lane < 26) shift_load(zr, hasp, hasn, 3072 + 16 * lane, wL);
        shift_comp(wR, 16 * lane, mp, mn, o); store16(R + (size_t)t * 1024 + 16 * lane, o);
        shift_comp(wV, 2048 + 16 * lane, mp, mn, o); store16(V + (size_t)t * 1024 + 16 * lane, o);
        if (lane < 26) shift_comp(wL, 3072 + 16 * lane, mp, mn, oL);
        shift_comp(wK, 1024 + 16 * lane, mp, mn, o); store16(KS + (size_t)t * 1024 + 16 * lane, o);
        float ss = 0.f;
#pragma unroll
        for (int j = 0; j < 16; ++j) { o[j] *= k_k[16 * lane + j]; ss += o[j] * o[j]; }
        ss = quad_sum(ss);
        const float rn = __builtin_amdgcn_rsqf(fmaxf(ss, 1e-12f));
#pragma unroll
        for (int j = 0; j < 16; ++j) o[j] *= rn;
        store16(KK + (size_t)t * 1024 + 16 * lane, o);
        if (lane < 32) {
            if (lane < 26) {
                if (lane < 8) {
#pragma unroll
                    for (int j = 0; j < 16; ++j) { const float e = ex2(2.0f * LOG2E * oL[j]); oL[j] = 1.0f - 2.0f * __builtin_amdgcn_rcpf(e + 1.0f); }
                } else if (lane >= 16) {
#pragma unroll
                    for (int j = 0; j < 16; ++j) oL[j] = sigm(oL[j]);
                } }
            else {
#pragma unroll
                for (int j = 0; j < 16; ++j) oL[j] = 0.f; }
            store16(AP + (size_t)t * 512 + 16 * lane, oL);
        }
    }
    __syncthreads();
    bf16* VT = (bf16*)(ws + WS_VT);
    LAS bf16* scr = (LAS bf16*)(F.lds + F.wave * 16640);
    for (int it = F.gw; it < NB * 8 * 32; it += F.NGW) {
        const int tb = it & 31, bh = it >> 5, b = bh >> 3, h = bh & 7;
        const bf16* src = Z + (size_t)(b * SEQ + tb * 64) * ZLD + 2048 + h * 128 + 2 * lane;
#pragma unroll 8
        for (int r = 0; r < 64; ++r) *(LAS unsigned*)(scr + r * 130 + 2 * lane) = *(const unsigned*)(src + (size_t)r * ZLD);
        LDS_WAIT(); asm volatile("" ::: "memory");
        const int dvr = lane >> 3, c = lane & 7;
#pragma unroll 4
        for (int i = 0; i < 16; ++i) { const int dv = 8 * i + dvr; const LAS bf16* s = scr + (8 * c) * 130 + dv;
            u32x4 w; w.x = (unsigned)s[0] | ((unsigned)s[130] << 16); w.y = (unsigned)s[260] | ((unsigned)s[390] << 16); w.z = (unsigned)s[520] | ((unsigned)s[650] << 16); w.w = (unsigned)s[780] | ((unsigned)s[910] << 16);
            *(u32x4*)(VT + ((size_t)bh * 128 + dv) * SEQ + tb * 64 + 8 * c) = w; }
        LDS_WAIT(); asm volatile("" ::: "memory");
    }
}

constexpr int ATT_KP = 272, ATT_VP = 144, ATT_KB = 64 * ATT_KP, ATT_VB = 128 * ATT_VP, ATT_BUF = ATT_KB + ATT_VB;
__device__ __forceinline__ void attn_phase(Frame& F) {
    unsigned char* ws = F.ws;
    const bf16* Z = (const bf16*)(ws + WS_Z); const bf16* VT = (const bf16*)(ws + WS_VT); bf16* YA = (bf16*)(ws + WS_YA);
    const int tid = F.tid, lane = F.lane, wave = F.wave, qs = wave & 3, map = wave >> 2, c = lane & 31, hh = lane >> 5;
    float lam;
    { const float a = wave_sum(F.in[5][lane] * F.in[6][lane]), b2 = wave_sum(F.in[7][lane] * F.in[8][lane]); lam = ex2(a * LOG2E) - ex2(b2 * LOG2E) + 0.2f; }
    const float* subg = F.in[9];
    LAS unsigned char* lds = F.lds;
    if (wave >= 4) __builtin_amdgcn_s_setprio(1);
    for (int ui = 0; ui < 4; ++ui) {
        if (F.vcu >= 256) break;
        const int b = F.vcu >> 5, qb = (F.vcu >> 1) & 15, ty = F.vcu & 1;
        const int h = (ui == 0) ? ty : (ui == 1) ? 7 - ty : (ui == 2) ? 3 - ty : 4 + ty;
        const int bh = b * 8 + h;
        const int tok0 = b * SEQ, q0 = qb * 128 + qs * 32;
        const float slope2 = ex2(-(float)(h + 1)) * LOG2E;
        const float sc2 = 0.125f * LOG2E;
        bf16x8 qf[4];
        { const bf16* qp = Z + (size_t)(tok0 + q0 + c) * ZLD + h * 128 + map * 64 + 8 * hh;
#pragma unroll
          for (int s = 0; s < 4; ++s) qf[s] = *(const bf16x8*)(qp + 16 * s); }
        f32x16 O[4];
#pragma unroll
        for (int d = 0; d < 4; ++d)
#pragma unroll
            for (int j = 0; j < 16; ++j) O[d][j] = 0.f;
        float mrun = -1e30f, muse = -1e30f, lrun = 0.f;
        const float cc = ex2((float)(2 - h)); const int q0w = q0;
        unsigned qaug1 = 0u, kaug1[2] = {0u, 0u};
        if (hh == 0) { qaug1 = cvt_pk_bf16((float)c, 1.0f);
#pragma unroll
          for (int kb = 0; kb < 2; ++kb) kaug1[kb] = cvt_pk_bf16(-cc, cc * (float)(32 * kb + c)); }
        const int dtile = q0w >> 6;
        unsigned koff[2], voff[2]; int kdst[2], vdst[2];
        const char* Zb = (const char*)(Z + (size_t)tok0 * ZLD + 1024 + h * 128); const char* Vb = (const char*)(VT + (size_t)bh * 128 * SEQ);
#pragma unroll
        for (int i = 0; i < 2; ++i) { const int q = tid + 512 * i;
            koff[i] = (unsigned)((q >> 4) * ZLD + (q & 15) * 8) * 2u; kdst[i] = (q >> 4) * ATT_KP + (q & 15) * 16;
            voff[i] = (unsigned)((q >> 3) * SEQ + (q & 7) * 8) * 2u; vdst[i] = ATT_KB + (q >> 3) * ATT_VP + ((q & 7) >> 1) * 32 + (q & 1) * 8; }
        u32x4 kr[2], vr[2];
        const int t0 = 2 * qb;
#pragma unroll
        for (int i = 0; i < 2; ++i) { kr[i] = *(const u32x4*)(Zb + (size_t)(t0 * 64) * ZLD * 2 + koff[i]); vr[i] = *(const u32x4*)(Vb + t0 * 64 * 2 + voff[i]); }
        int tlo, thi;
        { const unsigned* T = (const unsigned*)(ws + WS_CTL) + CW_QKN + b * 64 + h * 4;
          float bmax = 0.f;
#pragma unroll
          for (int mp = 0; mp < 2; ++mp) {
              const float q2 = __uint_as_float(__hip_atomic_load(T + mp * 2, __ATOMIC_RELAXED, __HIP_MEMORY_SCOPE_AGENT)) + __uint_as_float(__hip_atomic_load(T + mp * 2 + 1, __ATOMIC_RELAXED, __HIP_MEMORY_SCOPE_AGENT));
              const float k2 = __uint_as_float(__hip_atomic_load(T + 32 + mp * 2, __ATOMIC_RELAXED, __HIP_MEMORY_SCOPE_AGENT)) + __uint_as_float(__hip_atomic_load(T + 32 + mp * 2 + 1, __ATOMIC_RELAXED, __HIP_MEMORY_SCOPE_AGENT));
              bmax = fmaxf(bmax, q2 * k2); }
          const float Bb = __builtin_sqrtf(bmax) * sc2 * 1.02f;
          const float dk = fminf((30.0f + 2.0f * Bb) / slope2, 4096.0f);
          const int Di = __builtin_amdgcn_readfirstlane((int)dk + 1), q0b = qb * 128;
          const int a = q0b - 63 - Di; tlo = a <= 0 ? 0 : (a + 63) >> 6;
          const int e = (q0b + 127 + Di) >> 6; thi = e > 31 ? 31 : e; }
        const int nt = thi - tlo + 1;
#pragma unroll
        for (int i = 0; i < 2; ++i) { *(LAS u32x4*)(lds + kdst[i]) = kr[i]; *(LAS u32x2*)(lds + vdst[i]) = (u32x2){vr[i].x, vr[i].y}; *(LAS u32x2*)(lds + vdst[i] + 16) = (u32x2){vr[i].z, vr[i].w}; }
        __syncthreads();
        for (int it = 0; it < nt; ++it) {
            int xt = t0 - tlo + it; if (xt >= nt) xt -= nt;
            const int tt = tlo + xt, j0 = tt * 64; LAS unsigned char* buf = lds + (it & 1) * ATT_BUF;
            if (it + 1 < nt) { int xn = xt + 1; if (xn >= nt) xn -= nt; const int jn = (tlo + xn) * 64;
#pragma unroll
                for (int i = 0; i < 2; ++i) { kr[i] = *(const u32x4*)(Zb + (size_t)jn * ZLD * 2 + koff[i]); vr[i] = *(const u32x4*)(Vb + jn * 2 + voff[i]); } }
            const bool diag = (tt == dtile), left = (j0 < q0w);
            f32x16 S[2];
            { bf16x8 kf[2][4];
#pragma unroll
              for (int kb = 0; kb < 2; ++kb)
#pragma unroll
                for (int s = 0; s < 4; ++s) kf[kb][s] = *(const LAS bf16x8*)(buf + (32 * kb + c) * ATT_KP + (map * 64 + 16 * s + 8 * hh) * 2);
              __builtin_amdgcn_sched_barrier(0);
#pragma unroll
              for (int kb = 0; kb < 2; ++kb) {
#pragma unroll
                for (int j = 0; j < 16; ++j) S[kb][j] = 0.f;
#pragma unroll
                for (int s = 0; s < 4; ++s) S[kb] = __builtin_amdgcn_mfma_f32_32x32x16_bf16(kf[kb][s], qf[s], S[kb], 0, 0, 0); } }
            float tb2;
            if (!diag) {
#pragma unroll
                for (int kb = 0; kb < 2; ++kb) { u32x4 k = {kaug1[kb], 0u, 0u, 0u}; if (!left) k.x ^= 0x80008000u; const u32x4 qa = {qaug1, 0u, 0u, 0u};
                    S[kb] = __builtin_amdgcn_mfma_f32_32x32x16_bf16(__builtin_bit_cast(bf16x8, k), __builtin_bit_cast(bf16x8, qa), S[kb], 0, 0, 0); }
                tb2 = -slope2 * (float)(left ? (q0w - j0) : (j0 - q0w));
            } else {
                int dd0 = q0w + c - j0 - 4 * hh; asm volatile("" : "+v"(dd0));
#pragma unroll
                for (int kb = 0; kb < 2; ++kb)
#pragma unroll
                    for (int r = 0; r < 16; ++r) { const int dd = dd0 - (32 * kb + (r & 3) + 8 * (r >> 2)); S[kb][r] -= cc * (float)(dd < 0 ? -dd : dd); }
                tb2 = 0.f;
            }
            float mx = -1e30f;
#pragma unroll
            for (int kb = 0; kb < 2; ++kb)
#pragma unroll
                for (int r = 0; r < 16; ++r) mx = fmaxf(mx, S[kb][r]);
            mx = mx * sc2 + tb2;
            mx = fmaxf(mx, __shfl_xor(mx, 32));
            const float mnew = fmaxf(mrun, mx);
            const bool skip = __all(mx < mrun - 30.0f);
            mrun = mnew;
            if (!skip) {
                if (__any(mnew > muse + 8.0f)) {
                    const float alpha = ex2(muse - mnew); muse = mnew; lrun *= alpha;
#pragma unroll
                    for (int d = 0; d < 4; ++d)
#pragma unroll
                        for (int j = 0; j < 16; ++j) O[d][j] *= alpha; }
                const float off = tb2 - muse;
                float ls = 0.f; bf16x8 pf[2][2];
#pragma unroll
                for (int kb = 0; kb < 2; ++kb)
#pragma unroll
                    for (int s = 0; s < 2; ++s) { float p[8];
#pragma unroll
                        for (int j = 0; j < 8; ++j) { p[j] = ex2(__builtin_fmaf(S[kb][8 * s + j], sc2, off)); ls += p[j]; }
                        const u32x4 w = pack8(p); pf[kb][s] = __builtin_bit_cast(bf16x8, w); }
                lrun += ls;
                __builtin_amdgcn_sched_barrier(0);
                u32x4 vw[8];
#define ATT_VLOAD(i_) { vw[(i_) & 7] = *(const LAS u32x4*)(buf + ATT_KB + (32 * ((i_) >> 2) + c) * ATT_VP + ((i_) & 3) * 32 + hh * 16); }
#pragma unroll
                for (int i = 0; i < 8; ++i) ATT_VLOAD(i)
                __builtin_amdgcn_sched_barrier(0);
#pragma unroll
                for (int i = 0; i < 16; ++i) {
                    O[i >> 2] = __builtin_amdgcn_mfma_f32_32x32x16_bf16(__builtin_bit_cast(bf16x8, vw[i & 7]), pf[(i >> 1) & 1][i & 1], O[i >> 2], 0, 0, 0);
                    if (i + 8 < 16) ATT_VLOAD(i + 8)
                    __builtin_amdgcn_sched_barrier(0);
                }
#undef ATT_VLOAD
            }
            if (it + 1 < nt) { LAS unsigned char* nb = lds + ((it + 1) & 1) * ATT_BUF;
#pragma unroll
                for (int i = 0; i < 2; ++i) { *(LAS u32x4*)(nb + kdst[i]) = kr[i]; *(LAS u32x2*)(nb + vdst[i]) = (u32x2){vr[i].x, vr[i].y}; *(LAS u32x2*)(nb + vdst[i] + 16) = (u32x2){vr[i].z, vr[i].w}; } }
            __syncthreads();
        }
        const float ltot = lrun + __shfl_xor(lrun, 32); const float inv = __builtin_amdgcn_rcpf(ltot);
        LAS float* X = (LAS float*)lds;
        int tl = tid; asm volatile("" : "+v"(tl));
        const int c = tl & 31, hh = (tl >> 5) & 1, qs = (tl >> 6) & 3;
        if (map == 1) {
#pragma unroll
            for (int d = 0; d < 4; ++d)
#pragma unroll
                for (int g = 0; g < 4; ++g) { f32x4 v;
#pragma unroll
                    for (int j = 0; j < 4; ++j) v[j] = O[d][4 * g + j] * (inv * lam);
                    *(LAS f32x4*)(X + (qs * 32 + c) * 132 + 32 * d + 8 * g + 4 * hh) = v; }
        }
        __syncthreads();
        if (map == 0) {
            float ss = 0.f;
#pragma unroll
            for (int d = 0; d < 4; ++d)
#pragma unroll
                for (int g = 0; g < 4; ++g) { const f32x4 x = *(const LAS f32x4*)(X + (qs * 32 + c) * 132 + 32 * d + 8 * g + 4 * hh);
#pragma unroll
                    for (int j = 0; j < 4; ++j) { const float o = O[d][4 * g + j] * inv - x[j]; O[d][4 * g + j] = o; ss += o * o; } }
            ss += __shfl_xor(ss, 32);
            const float rn = __builtin_amdgcn_rsqf(ss * (1.f / 128.f) + RMS_EPS) * 0.8f;
            bf16* yp = YA + (size_t)(tok0 + q0 + c) * 1024 + h * 128;
            f32x4 sgv[4][4];
#pragma unroll
            for (int d = 0; d < 4; ++d)
#pragma unroll
                for (int g = 0; g < 4; ++g) sgv[d][g] = *(const f32x4*)(subg + 32 * d + 8 * g + 4 * hh);
#pragma unroll
            for (int d = 0; d < 4; ++d)
#pragma unroll
                for (int g = 0; g < 4; ++g) { const int dv = 32 * d + 8 * g + 4 * hh; const f32x4 sg = sgv[d][g];
                    u32x2 w; w.x = cvt_pk_bf16(O[d][4 * g] * rn * sg[0], O[d][4 * g + 1] * rn * sg[1]); w.y = cvt_pk_bf16(O[d][4 * g + 2] * rn * sg[2], O[d][4 * g + 3] * rn * sg[3]);
                    *(u32x2*)(yp + dv) = w; }
        }
        __syncthreads();
    }
    __builtin_amdgcn_s_setprio(0);
}

constexpr int SCN_VEC = 0, SCN_WLO = 8192, SCN_WHI = SCN_WLO + 4352, SCN_KB = SCN_WHI + 4352, SCN_V = SCN_KB + 8704, SCN_SC = SCN_V + 8192, SCN_BUF = SCN_SC + 512;
constexpr int SCN_YST = 2 * SCN_BUF, SCN_END = SCN_YST + 2 * 8192;
static_assert(SCN_END <= LDSCTL_OFF, "scan LDS map");
struct ScanRegs { u32x2 r, kk, v, kt, bv, dd; };
template <bool CONV> __device__ __forceinline__ void scan_phase(Frame& F) {
    unsigned char* ws = F.ws;
    const int tid = F.tid, seq = F.vcu; if (seq >= 256) return;
    const int dir = seq >> 7, b = (seq >> 4) & 7, h = seq & 15;
    const bf16* R = (const bf16*)(ws + WS_R); const bf16* KK = (const bf16*)(ws + WS_KK); const bf16* V = (const bf16*)(ws + WS_V);
    const bf16* KT = (const bf16*)(ws + WS_KT) + (size_t)dir * NTOK * 1024; const bf16* BV = (const bf16*)(ws + WS_BV) + (size_t)dir * NTOK * 1024;
    const bf16* DD = (const bf16*)(ws + WS_WD) + (size_t)dir * NTOK * 1024; bf16* YS = (bf16*)(ws + WS_YS) + (size_t)dir * NTOK * 1024;
    LAS unsigned char* L = F.lds;
    for (int k = tid; k < 2 * 16 * 16; k += 512) { const int bi = k >> 8, r2 = k & 255, st = r2 >> 4, w = r2 & 15;
        const int off = (w < 4) ? SCN_WLO + st * 272 + 256 + 4 * w : (w < 8) ? SCN_WHI + st * 272 + 256 + 4 * (w - 4) : SCN_KB + st * 544 + 512 + 4 * (w - 8);
        *(LAS unsigned*)(L + bi * SCN_BUF + off) = 0u; }
    const int t4 = tid & 255, part = t4 & 15, lsA = t4 >> 4, lsB = lsA + 16;
    auto gload = [&](ScanRegs& g, int cchunk, int ls) { const int tt = cchunk * 32 + ls; const int t = dir ? (SEQ - 1 - tt) : tt; const size_t o = (size_t)(b * SEQ + t) * 1024 + h * 64 + 4 * part;
        g.r = *(const u32x2*)(R + o); g.kk = *(const u32x2*)(KK + o); g.v = *(const u32x2*)(V + o); g.kt = *(const u32x2*)(KT + o); g.bv = *(const u32x2*)(BV + o); g.dd = *(const u32x2*)(DD + o); };
    auto lstore = [&](const ScanRegs& g, int bi, int ls) { LAS unsigned char* B = L + bi * SCN_BUF; const int pr = ls >> 1; const bool odd = ls & 1;
        const f32x4 lw = 1.0f - (f32x4){bflo(g.dd.x), bfhi(g.dd.x), bflo(g.dd.y), bfhi(g.dd.y)};
        const f32x4 r = {bflo(g.r.x), bfhi(g.r.x), bflo(g.r.y), bfhi(g.r.y)}, kk = {bflo(g.kk.x), bfhi(g.kk.x), bflo(g.kk.y), bfhi(g.kk.y)}, v = {bflo(g.v.x), bfhi(g.v.x), bflo(g.v.y), bfhi(g.v.y)};
        const f32x4 kt = {bflo(g.kt.x), bfhi(g.kt.x), bflo(g.kt.y), bfhi(g.kt.y)}, bb = {bflo(g.bv.x), bfhi(g.bv.x), bflo(g.bv.y), bfhi(g.bv.y)};
        f32x4 wp; wp.x = __shfl_xor(lw.x, 16); wp.y = __shfl_xor(lw.y, 16); wp.z = __shfl_xor(lw.z, 16); wp.w = __shfl_xor(lw.w, 16);
        const unsigned pk0 = __shfl_xor(g.kk.x, 16), pk1 = __shfl_xor(g.kk.y, 16), pr0 = __shfl_xor(g.r.x, 16), pr1 = __shfl_xor(g.r.y, 16);
        const f32x4 kkp = {bflo(pk0), bfhi(pk0), bflo(pk1), bfhi(pk1)}, rp = {bflo(pr0), bfhi(pr0), bflo(pr1), bfhi(pr1)};
        float s0, s1, s2 = 0.f, s3 = 0.f, s4 = 0.f, s5 = 0.f;
        s0 = (bb.x * r.x + bb.y * r.y) + (bb.z * r.z + bb.w * r.w);
        s1 = (kt.x * r.x + kt.y * r.y) + (kt.z * r.z + kt.w * r.w);
        if (!odd) {
            const f32x4 wr = lw * r, w01 = lw * wp, ktw = kt * wp, bbw = bb * wp;
            *(LAS u32x2*)(B + SCN_VEC + pr * 512 + 8 * part) = g.kk;
            *(LAS u32x2*)(B + SCN_VEC + pr * 512 + 128 + 8 * part) = (u32x2){cvt_pk_bf16(wr.x, wr.y), cvt_pk_bf16(wr.z, wr.w)};
            const u32x4 wl = {cvt_pk_bf16(w01.x, 0.f), cvt_pk_bf16(w01.y, 0.f), cvt_pk_bf16(w01.z, 0.f), cvt_pk_bf16(w01.w, 0.f)};
            *(LAS u32x4*)(B + SCN_WLO + pr * 272 + 16 * part) = wl;
            *(LAS u32x4*)(B + SCN_WHI + pr * 272 + 16 * part) = (u32x4){wl.x << 16, wl.y << 16, wl.z << 16, wl.w << 16};
            LAS unsigned* kb = (LAS unsigned*)(B + SCN_KB + pr * 544 + 32 * part);
            kb[0] = cvt_pk_bf16(ktw.x, -bbw.x); kb[2] = cvt_pk_bf16(ktw.y, -bbw.y); kb[4] = cvt_pk_bf16(ktw.z, -bbw.z); kb[6] = cvt_pk_bf16(ktw.w, -bbw.w);
            *(LAS f32x4*)(B + SCN_V + pr * 512 + 16 * part) = v;
            s2 = (kt.x * kkp.x + kt.y * kkp.y) + (kt.z * kkp.z + kt.w * kkp.w);
            s3 = (bb.x * kkp.x + bb.y * kkp.y) + (bb.z * kkp.z + bb.w * kkp.w);
            s4 = (ktw.x * rp.x + ktw.y * rp.y) + (ktw.z * rp.z + ktw.w * rp.w);
            s5 = (bbw.x * rp.x + bbw.y * rp.y) + (bbw.z * rp.z + bbw.w * rp.w);
        } else {
            const f32x4 qk = wp * kk, qr = wp * lw * r;
            *(LAS u32x2*)(B + SCN_VEC + pr * 512 + 256 + 8 * part) = (u32x2){cvt_pk_bf16(qk.x, qk.y), cvt_pk_bf16(qk.z, qk.w)};
            *(LAS u32x2*)(B + SCN_VEC + pr * 512 + 384 + 8 * part) = (u32x2){cvt_pk_bf16(qr.x, qr.y), cvt_pk_bf16(qr.z, qr.w)};
            LAS unsigned* kb = (LAS unsigned*)(B + SCN_KB + pr * 544 + 32 * part);
            kb[1] = cvt_pk_bf16(kt.x, -bb.x); kb[3] = cvt_pk_bf16(kt.y, -bb.y); kb[5] = cvt_pk_bf16(kt.z, -bb.z); kb[7] = cvt_pk_bf16(kt.w, -bb.w);
            *(LAS f32x4*)(B + SCN_V + pr * 512 + 256 + 16 * part) = v;
        }
#pragma unroll
        for (int o = 0; o < 1; ++o) { s0 = row16_sum(s0); s1 = row16_sum(s1); s2 = row16_sum(s2); s3 = row16_sum(s3); s4 = row16_sum(s4); s5 = row16_sum(s5); }
        if (part == 0) { LAS float* sc = (LAS float*)(B + SCN_SC + pr * 32);
            if (!odd) { sc[0] = s0; sc[1] = s1; sc[2] = s2; sc[3] = s3; sc[4] = s4; sc[5] = s5; } else { sc[6] = s0; sc[7] = s1; } } };
    auto ystore = [&](int cchunk, int ls) { const LAS float* Y = (const LAS float*)(L + SCN_YST + (cchunk & 1) * 8192); const int tt = cchunk * 32 + ls; const int t = dir ? (SEQ - 1 - tt) : tt;
        const f32x4 yv = *(const LAS f32x4*)(Y + ls * 64 + 4 * part);
        *(u32x2*)(YS + (size_t)(b * SEQ + t) * 1024 + h * 64 + 4 * part) = (u32x2){cvt_pk_bf16(yv.x, yv.y), cvt_pk_bf16(yv.z, yv.w)}; };
    const int lane = F.lane, m = lane & 15, q = lane >> 4, wv = F.wave & 3;
    const bool act = (q == (m >> 2));
    const int o_vec = SCN_VEC + (m & 3) * 128 + 8 * q, o_v = SCN_V + 4 * (16 * wv + m);
    int o_w0[4], o_w1[4], o_kb[4];
#pragma unroll
    for (int t = 0; t < 4; ++t) { const int j = 16 * t + m, wsel = ((m & 1) ? SCN_WHI : SCN_WLO) + 4 * j, zero = SCN_WLO + 256;
        o_w0[t] = (act && (m & 3) < 2) ? wsel : zero; o_w1[t] = (act && (m & 3) >= 2) ? wsel : zero; o_kb[t] = SCN_KB + ((q == 0) ? 8 * j : 512); }
    f32x4 St[4];
#pragma unroll
    for (int t = 0; t < 4; ++t) St[t] = (f32x4){0.f, 0.f, 0.f, 0.f};
    ScanRegs gA{}, gB{};
    const bool loader = tid >= 256;
    if (loader) { gload(gA, 0, lsA); gload(gB, 0, lsB); lstore(gA, 0, lsA); lstore(gB, 0, lsB); gload(gA, 1, lsA); gload(gB, 1, lsB); }
    __syncthreads();
    for (int cch = 0; cch < 64; ++cch) {
        const int bi = cch & 1;
        if (!loader) {
            const LAS unsigned char* B = L + bi * SCN_BUF; LAS float* YST = (LAS float*)(L + SCN_YST + bi * 8192);
            const LAS unsigned char* p_vec = B + o_vec; const LAS unsigned char* p_v = B + o_v;
            const LAS unsigned char* p_w0[4]; const LAS unsigned char* p_w1[4]; const LAS unsigned char* p_kb[4];
#pragma unroll
            for (int t = 0; t < 4; ++t) { p_w0[t] = B + o_w0[t]; p_w1[t] = B + o_w1[t]; p_kb[t] = B + o_kb[t]; }
#pragma unroll
            for (int p = 0; p < 16; ++p) {
                const u32x2 a0 = *(const LAS u32x2*)(p_vec + p * 512), a1 = *(const LAS u32x2*)(p_vec + p * 512 + 32), a2 = *(const LAS u32x2*)(p_vec + p * 512 + 64), a3 = *(const LAS u32x2*)(p_vec + p * 512 + 96);
                unsigned w0[4], w1[4]; u32x2 kb[4];
#pragma unroll
                for (int t = 0; t < 4; ++t) { w0[t] = *(const LAS unsigned*)(p_w0[t] + p * 272); w1[t] = *(const LAS unsigned*)(p_w1[t] + p * 272); kb[t] = *(const LAS u32x2*)(p_kb[t] + p * 544); }
                const float v0 = *(const LAS float*)(p_v + p * 512), v1 = *(const LAS float*)(p_v + p * 512 + 256);
                const f32x4 c0 = *(const LAS f32x4*)(B + SCN_SC + p * 32), c1 = *(const LAS f32x4*)(B + SCN_SC + p * 32 + 16);
                unsigned bp[4][2];
#pragma unroll
                for (int t = 0; t < 4; ++t) { bp[t][0] = cvt_pk_bf16_hz(St[t][0], St[t][1]); bp[t][1] = cvt_pk_bf16_hz(St[t][2], St[t][3]); }
                f32x4 P = {0.f, 0.f, 0.f, 0.f};
                P = __builtin_amdgcn_mfma_f32_16x16x32_bf16(__builtin_bit_cast(bf16x8, ((u32x4){a0.x, a0.y, a1.x, a1.y})), __builtin_bit_cast(bf16x8, ((u32x4){bp[0][0], bp[0][1], bp[1][0], bp[1][1]})), P, 0, 0, 0);
                P = __builtin_amdgcn_mfma_f32_16x16x32_bf16(__builtin_bit_cast(bf16x8, ((u32x4){a2.x, a2.y, a3.x, a3.y})), __builtin_bit_cast(bf16x8, ((u32x4){bp[2][0], bp[2][1], bp[3][0], bp[3][1]})), P, 0, 0, 0);
                const float sa0 = P[0];
                const float sa1 = P[2] - sa0 * c0.w + v0 * c0.z;
                const float y0 = P[1] - sa0 * c0.x + v0 * c0.y;
                const float y1 = P[3] - sa0 * c1.y + v0 * c1.x - sa1 * c1.z + v1 * c1.w;
                YST[(2 * p) * 64 + 16 * wv + m] = y0; YST[(2 * p + 1) * 64 + 16 * wv + m] = y1;
                const unsigned vs0 = cvt_pk_bf16_hz(v0, sa0), vs1 = cvt_pk_bf16_hz(v1, sa1);
#pragma unroll
                for (int t = 0; t < 4; ++t)
                    St[t] = __builtin_amdgcn_mfma_f32_16x16x32_bf16(__builtin_bit_cast(bf16x8, ((u32x4){w0[t], w1[t], kb[t].x, kb[t].y})), __builtin_bit_cast(bf16x8, ((u32x4){bp[t][0], bp[t][1], vs0, vs1})), (f32x4){0.f, 0.f, 0.f, 0.f}, 0, 0, 0);
            }
        } else {
            ConvQ cq{}; f32x4 cv[16]; bool conv = false;
            if constexpr (CONV) { const int n0 = (cch * 49) >> 6, n1 = ((cch + 1) * 49) >> 6; const int it = F.vcu * 4 + (F.wave - 4) + 1024 * n0;
                conv = (n1 > n0) && it < 65 * 768;
                if (conv) { cq = conv_quad_item(F.in, F.ws, it, lane); conv_quad_load(cq, cv); } }
            if (cch + 1 < 64) { lstore(gA, bi ^ 1, lsA); lstore(gB, bi ^ 1, lsB); }
            if (cch + 2 < 64) { gload(gA, cch + 2, lsA); gload(gB, cch + 2, lsB); }
            if (cch >= 1) { ystore(cch - 1, lsA); ystore(cch - 1, lsB); }
            if constexpr (CONV) { if (conv) conv_quad_store(cq, cv); }
        }
        __syncthreads();
    }
    if (loader) { ystore(63, lsA); ystore(63, lsB); }
}

struct P5Raw { u32x4 ya[2], yb[2], r[2], k0[2], k1[2], v[2], g[2]; };
__device__ __forceinline__ void p5_post(Frame& F) {
    unsigned char* ws = F.ws; const int lane = F.lane;
    const bf16* YS = (const bf16*)(ws + WS_YS); const bf16* R = (const bf16*)(ws + WS_R); const bf16* V = (const bf16*)(ws + WS_V); const bf16* KT = (const bf16*)(ws + WS_KT);
    const bf16* GG = (const bf16*)(ws + WS_G); bf16* YR = (bf16*)(ws + WS_YR);
    const float* r_k = F.in[19]; const float* lg = F.in[20]; const float* lb = F.in[21];
    auto ld = [&](int t, P5Raw& w) { const size_t o = (size_t)t * 1024 + 16 * lane;
#pragma unroll
        for (int hh = 0; hh < 2; ++hh) { w.ya[hh] = *(const u32x4*)(YS + o + 8 * hh); w.yb[hh] = *(const u32x4*)(YS + (size_t)NTOK * 1024 + o + 8 * hh); w.r[hh] = *(const u32x4*)(R + o + 8 * hh);
            w.k0[hh] = *(const u32x4*)(KT + o + 8 * hh); w.k1[hh] = *(const u32x4*)(KT + (size_t)NTOK * 1024 + o + 8 * hh); w.v[hh] = *(const u32x4*)(V + o + 8 * hh); w.g[hh] = *(const u32x4*)(GG + o + 8 * hh); } };
    auto fin = [&](int t, const P5Raw& w) { const size_t o = (size_t)t * 1024 + 16 * lane;
        float y[16], r[16], k0[16], k1[16], v[16], g[16];
#pragma unroll
        for (int hh = 0; hh < 2; ++hh) { float ta[8], tb[8];
            unpack8(w.ya[hh], ta); unpack8(w.yb[hh], tb);
#pragma unroll
            for (int j = 0; j < 8; ++j) y[8 * hh + j] = ta[j] + tb[j];
            unpack8(w.r[hh], ta); unpack8(w.k0[hh], tb);
#pragma unroll
            for (int j = 0; j < 8; ++j) { r[8 * hh + j] = ta[j]; k0[8 * hh + j] = tb[j]; }
            unpack8(w.k1[hh], ta); unpack8(w.v[hh], tb);
#pragma unroll
            for (int j = 0; j < 8; ++j) { k1[8 * hh + j] = ta[j]; v[8 * hh + j] = tb[j]; }
            unpack8(w.g[hh], ta);
#pragma unroll
            for (int j = 0; j < 8; ++j) g[8 * hh + j] = ta[j]; }
        float s = 0.f, cf = 0.f;
#pragma unroll
        for (int j = 0; j < 16; ++j) { s += y[j]; cf += r[j] * (k0[j] + k1[j]) * r_k[16 * lane + j]; }
        s = quad_sum(s); cf = quad_sum(cf);
        const float mu = s * (1.f / 64.f); float q2 = 0.f;
#pragma unroll
        for (int j = 0; j < 16; ++j) { y[j] -= mu; q2 += y[j] * y[j]; }
        q2 = quad_sum(q2);
        const float rs = __builtin_amdgcn_rsqf(q2 * (1.f / 64.f) + GN_EPS);
#pragma unroll
        for (int j = 0; j < 16; ++j) y[j] = (y[j] * rs * lg[16 * lane + j] + lb[16 * lane + j] + cf * v[j]) * g[j];
        store16(YR + o, y); };
    for (int t = F.gw; t < NTOK; t += 2 * F.NGW) {
        const int t2 = t + F.NGW; P5Raw wa, wb;
        ld(t, wa); if (t2 < NTOK) ld(t2, wb);
        fin(t, wa); if (t2 < NTOK) fin(t2, wb);
    }
}

__device__ __forceinline__ void p8_route(Frame& F) {
    unsigned char* ws = F.ws; const int lane = F.lane, r = lane & 31, hh = lane >> 5, wave = F.wave;
    const bf16* H1 = (const bf16*)(ws + WS_HRES); const bf16* WF = (const bf16*)(ws + WS_WRT);
    LAS float* LG = (LAS float*)F.lds;
    LAS float* SQ = LG + 4 * 64 * 64;
    LAS int* hist = (LAS int*)(SQ + 256);
    if (F.tid < 64) hist[F.tid] = 0;
    { const int th = wave >> 2, kq = wave & 3; const int tok0 = F.vcu * 64 + th * 32;
        f32x16 a0, a1;
#pragma unroll
        for (int j = 0; j < 16; ++j) { a0[j] = 0.f; a1[j] = 0.f; }
        float sq = 0.f;
        const bf16* hp = H1 + (size_t)(tok0 + r) * DM + kq * 512 + 8 * hh;
        const bf16* wf = WF + (size_t)kq * 32 * 2048 + lane * 8;
#pragma unroll 4
        for (int s = 0; s < 32; ++s) {
            const u32x4 aw = *(const u32x4*)(hp + 16 * s); const bf16x8 a = __builtin_bit_cast(bf16x8, aw);
            { float f[8]; unpack8(aw, f);
#pragma unroll
              for (int j = 0; j < 8; ++j) sq += f[j] * f[j]; }
            const bf16x8 bh0 = *(const bf16x8*)(wf + 2048 * s), bl0 = *(const bf16x8*)(wf + 2048 * s + 512), bh1 = *(const bf16x8*)(wf + 2048 * s + 1024), bl1 = *(const bf16x8*)(wf + 2048 * s + 1536);
            a0 = __builtin_amdgcn_mfma_f32_32x32x16_bf16(a, bh0, a0, 0, 0, 0); a0 = __builtin_amdgcn_mfma_f32_32x32x16_bf16(a, bl0, a0, 0, 0, 0);
            a1 = __builtin_amdgcn_mfma_f32_32x32x16_bf16(a, bh1, a1, 0, 0, 0); a1 = __builtin_amdgcn_mfma_f32_32x32x16_bf16(a, bl1, a1, 0, 0, 0);
        }
        sq += __shfl_xor(sq, 32);
        if (hh == 0) SQ[kq * 64 + th * 32 + r] = sq;
        LAS float* lp = LG + (kq * 64 + th * 32) * 64;
#pragma unroll
        for (int j = 0; j < 16; ++j) { const int row = (j & 3) + 8 * (j >> 2) + 4 * hh; lp[row * 64 + r] = a0[j]; lp[row * 64 + 32 + r] = a1[j]; }
    }
    __syncthreads();
    int* TOPI = (int*)(ws + WS_TOPI); float* TOPG = (float*)(ws + WS_TOPG); int* WGCNT = (int*)(ws + WS_WGCNT);
    unsigned char* U8 = ws + WS_U; const float* gffn = F.in[25]; const float* brt = F.in[27];
    int mycnt = 0;
    {
        float score[8], sel[8], gs[8], gsum[8], rstd[8]; int myk[8];
#pragma unroll
        for (int q = 0; q < 8; ++q) { const int tl = wave * 8 + q;
            const float ss = (SQ[tl] + SQ[64 + tl]) + (SQ[128 + tl] + SQ[192 + tl]);
            rstd[q] = __builtin_amdgcn_rsqf(ss * (1.f / DM) + RMS_EPS);
            const float lg = ((LG[tl * 64 + lane] + LG[(64 + tl) * 64 + lane]) + (LG[(128 + tl) * 64 + lane] + LG[(192 + tl) * 64 + lane])) * rstd[q];
            score[q] = 1.0f / (1.0f + __expf(-lg)); sel[q] = score[q] + brt[lane]; gs[q] = 0.f; gsum[q] = 0.f; myk[q] = -1; }
#pragma unroll
        for (int k = 0; k < 8; ++k) {
            float bv[8]; int bi[8];
#pragma unroll
            for (int q = 0; q < 8; ++q) { bv[q] = sel[q]; bi[q] = lane; }
#define TOP8_STEP(OV, OI) { _Pragma("unroll") for (int q = 0; q < 8; ++q) { const float ov_ = (OV); const int oi_ = (OI); if (ov_ > bv[q] || (ov_ == bv[q] && oi_ < bi[q])) { bv[q] = ov_; bi[q] = oi_; } } }
            TOP8_STEP(dppf<DPP_X1>(bv[q]), dppi<DPP_X1>(bi[q]))
            TOP8_STEP(dppf<DPP_X2>(bv[q]), dppi<DPP_X2>(bi[q]))
            TOP8_STEP(dppf<DPP_HM>(bv[q]), dppi<DPP_HM>(bi[q]))
            TOP8_STEP(dppf<DPP_RM>(bv[q]), dppi<DPP_RM>(bi[q]))
#undef TOP8_STEP
#pragma unroll
            for (int o = 16; o < 64; o <<= 1) {
                float ov[8]; int oi[8];
#pragma unroll
                for (int q = 0; q < 8; ++q) { ov[q] = __shfl_xor(bv[q], o); oi[q] = __shfl_xor(bi[q], o); }
#pragma unroll
                for (int q = 0; q < 8; ++q) if (ov[q] > bv[q] || (ov[q] == bv[q] && oi[q] < bi[q])) { bv[q] = ov[q]; bi[q] = oi[q]; } }
            float sc[8];
#pragma unroll
            for (int q = 0; q < 8; ++q) sc[q] = __shfl(score[q], bi[q]);
#pragma unroll
            for (int q = 0; q < 8; ++q) { gsum[q] += sc[q]; if (lane == bi[q]) { sel[q] = -1e30f; myk[q] = k; gs[q] = sc[q]; mycnt++; } }
        }
#pragma unroll
        for (int q = 0; q < 8; ++q) { const int t = F.vcu * 64 + wave * 8 + q;
            if (myk[q] >= 0) { TOPI[t * 8 + myk[q]] = lane; TOPG[t * 8 + myk[q]] = gs[q] / gsum[q] * 2.5f; } }
        f32x4 gg[8];
#pragma unroll
        for (int j = 0; j < 8; ++j) gg[j] = ((const f32x4*)gffn + lane)[64 * j];
#pragma unroll
        for (int qb4 = 0; qb4 < 2; ++qb4) { u32x2 vw[4][8];
#pragma unroll
            for (int q = 0; q < 4; ++q) { const u32x2* xr = (const u32x2*)(H1 + (size_t)(F.vcu * 64 + wave * 8 + qb4 * 4 + q) * DM) + lane;
#pragma unroll
                for (int j = 0; j < 8; ++j) vw[q][j] = xr[64 * j]; }
#pragma unroll
            for (int q = 0; q < 4; ++q) { const float rs = rstd[qb4 * 4 + q]; unsigned* o4 = (unsigned*)(U8 + (size_t)(F.vcu * 64 + wave * 8 + qb4 * 4 + q) * DM) + lane;
#pragma unroll
                for (int j = 0; j < 8; ++j) { const f32x4 v = {bflo(vw[q][j].x), bfhi(vw[q][j].x), bflo(vw[q][j].y), bfhi(vw[q][j].y)}; o4[64 * j] = pk4_fp8(v.x * rs * gg[j].x, v.y * rs * gg[j].y, v.z * rs * gg[j].z, v.w * rs * gg[j].w); } } }
    }
    atomicAdd((int*)&hist[lane], mycnt);
    __syncthreads();
    if (F.tid < 64) WGCNT[F.vcu * 64 + F.tid] = hist[F.tid];
}

__device__ __forceinline__ void p10_slots(Frame& F) {
    unsigned char* ws = F.ws; const int tid = F.tid;
    const int* TOPI = (const int*)(ws + WS_TOPI); const float* TOPG = (const float*)(ws + WS_TOPG); const int* WGCNT = (const int*)(ws + WS_WGCNT);
    int* MISC = (int*)(ws + WS_MISC); int* STOK = (int*)(ws + WS_SLOT_TOK); int* SDST = (int*)(ws + WS_SLOT_DST); float* SG = (float*)(ws + WS_SLOT_G);
    LAS int* L = (LAS int*)F.lds;
    const int G = F.G, me = F.vcu;
    { const int e = tid & 63, part = tid >> 6; int tot = 0, bef = 0;
      for (int w = part * 32; w < part * 32 + 32 && w < G; ++w) { const int cnt = WGCNT[w * 64 + e]; tot += cnt; if (w < me) bef += cnt; }
      L[part * 64 + e] = tot; L[512 + part * 64 + e] = bef; }
    __syncthreads();
    if (tid < 64) { int tot = 0, bef = 0;
#pragma unroll
        for (int p = 0; p < 8; ++p) { tot += L[p * 64 + tid]; bef += L[512 + p * 64 + tid]; }
        L[1024 + tid] = tot; L[1088 + tid] = bef; L[1216 + tid] = (tot + 255) & ~255; }
    __syncthreads();
    if (tid == 0) { int acc = 0; for (int e = 0; e < 64; ++e) { L[1152 + e] = acc; acc += L[1216 + e]; } }
    { const int t = me * 64 + (tid >> 3); L[1280 + tid] = TOPI[t * 8 + (tid & 7)]; }
    __syncthreads();
    { const int e = L[1280 + tid]; int rank = 0;
      for (int p = 0; p < tid; ++p) rank += (L[1280 + p] == e) ? 1 : 0;
      const int slot = L[1152 + e] + L[1088 + e] + rank; const int t = me * 64 + (tid >> 3), k = tid & 7;
      STOK[slot] = t; SDST[slot] = t * 9 + k; SG[slot] = TOPG[t * 8 + k]; }
    if (tid < 64) { const int t = me * 64 + tid; STOK[RCAP + t] = t; SDST[RCAP + t] = t * 9 + 8; SG[RCAP + t] = 1.0f; }
    for (int e = me; e < 64; e += G) {
        const int s0 = L[1152 + e] + L[1024 + e], s1 = L[1152 + e] + L[1216 + e];
        for (int s = s0 + tid; s < s1; s += 512) { STOK[s] = 0; SDST[s] = -1; SG[s] = 0.f; } }
    if (me == 0) {
        if (tid < 64) { MISC[MI_TOTAL + tid] = L[1024 + tid]; MISC[MI_PADDED + tid] = L[1216 + tid]; MISC[MI_PSTART + tid] = L[1152 + tid]; }
        if (tid < 64) { const int n0 = L[1152 + tid] >> 8, cntt = L[1216 + tid] >> 8;
            for (int m = 0; m < cntt; ++m) { MISC[MI_TILE_E + n0 + m] = tid; MISC[MI_TILE_R0 + n0 + m] = L[1152 + tid] + 256 * m; }
            const int nr = (L[1152 + 63] + L[1216 + 63]) >> 8;
            MISC[MI_TILE_E + nr + tid] = 64; MISC[MI_TILE_R0 + nr + tid] = RCAP + 256 * tid;
            if (tid == 0) MISC[MI_NT] = nr + 64; }
    }
}

__device__ __forceinline__ void combine_phase(Frame& F) {
    unsigned char* ws = F.ws; const int lane = F.lane;
    const unsigned char* Y = ws + WS_Y; unsigned char* U8 = ws + WS_U; bf16* H = (bf16*)(ws + WS_HRES); const float* gple = F.in[34];
    f32x4 gg[2][4];
#pragma unroll
    for (int hf = 0; hf < 2; ++hf)
#pragma unroll
        for (int q = 0; q < 4; ++q) gg[hf][q] = *(const f32x4*)(gple + hf * 1024 + 16 * lane + 4 * q);
    for (int t = F.gw; t < NTOK; t += F.NGW) {
        u32x4 hw[2][2], yw[2][9];
#pragma unroll
        for (int hf = 0; hf < 2; ++hf) { const bf16* hp = H + (size_t)t * DM + hf * 1024 + 16 * lane; hw[hf][0] = *(const u32x4*)hp; hw[hf][1] = *(const u32x4*)(hp + 8);
#pragma unroll
            for (int k = 0; k < 9; ++k) yw[hf][k] = *(const u32x4*)(Y + ((size_t)t * 9 + k) * 2048 + hf * 1024 + 16 * lane); }
        float a[2][16]; float ss = 0.f;
#pragma unroll
        for (int hf = 0; hf < 2; ++hf) {
            bf16* hp = H + (size_t)t * DM + hf * 1024 + 16 * lane;
            { float lo8[8], hi8[8]; unpack8(hw[hf][0], lo8); unpack8(hw[hf][1], hi8);
#pragma unroll
              for (int j = 0; j < 8; ++j) { a[hf][j] = lo8[j]; a[hf][8 + j] = hi8[j]; } }
#pragma unroll
            for (int k = 0; k < 9; ++k) {
#pragma unroll
                for (int d = 0; d < 4; ++d) { const f32x2 lo = __builtin_amdgcn_cvt_pk_f32_fp8((int)yw[hf][k][d], false), hi = __builtin_amdgcn_cvt_pk_f32_fp8((int)yw[hf][k][d], true);
                    a[hf][4 * d] += lo.x * 0.0625f; a[hf][4 * d + 1] += lo.y * 0.0625f; a[hf][4 * d + 2] += hi.x * 0.0625f; a[hf][4 * d + 3] += hi.y * 0.0625f; } }
#pragma unroll
            for (int q = 0; q < 2; ++q) { u32x4 w; w.x = cvt_pk_bf16(a[hf][8 * q], a[hf][8 * q + 1]); w.y = cvt_pk_bf16(a[hf][8 * q + 2], a[hf][8 * q + 3]); w.z = cvt_pk_bf16(a[hf][8 * q + 4], a[hf][8 * q + 5]); w.w = cvt_pk_bf16(a[hf][8 * q + 6], a[hf][8 * q + 7]);
                *(u32x4*)(hp + 8 * q) = w; }
#pragma unroll
            for (int j = 0; j < 16; ++j) ss += a[hf][j] * a[hf][j];
        }
        const float rstd = __builtin_amdgcn_rsqf(wave_sum(ss) * (1.f / DM) + RMS_EPS);
#pragma unroll
        for (int hf = 0; hf < 2; ++hf) { float c[16];
#pragma unroll
            for (int j = 0; j < 16; ++j) c[j] = a[hf][j] * rstd * gg[hf][j >> 2][j & 3];
            u32x4 w; w.x = pk4_fp8(c[0], c[1], c[2], c[3]); w.y = pk4_fp8(c[4], c[5], c[6], c[7]); w.z = pk4_fp8(c[8], c[9], c[10], c[11]); w.w = pk4_fp8(c[12], c[13], c[14], c[15]);
            *(u32x4*)(U8 + (size_t)t * DM + hf * 1024 + 16 * lane) = w; }
    }
}

__device__ __forceinline__ void final_phase(Frame& F) {
    const float* g = F.in[37];
    f32x4 gg[8];
#pragma unroll
    for (int j = 0; j < 8; ++j) gg[j] = ((const f32x4*)g + F.lane)[64 * j];
    for (int m = F.gw; m < NTOK; m += 2 * F.NGW) {
        const int m2 = m + F.NGW;
        u32x2 hw[2][8];
#pragma unroll
        for (int r = 0; r < 2; ++r) { const int mm = r ? m2 : m; if (mm < NTOK) { const u32x2* hr = (const u32x2*)((const bf16*)(F.ws + WS_HRES) + (size_t)mm * DM) + F.lane;
#pragma unroll
            for (int j = 0; j < 8; ++j) hw[r][j] = hr[64 * j]; } }
#pragma unroll
        for (int r = 0; r < 2; ++r) { const int mm = r ? m2 : m; if (mm < NTOK) {
            f32x4 v[8]; float s = 0.f;
#pragma unroll
            for (int j = 0; j < 8; ++j) { v[j] = (f32x4){bflo(hw[r][j].x), bfhi(hw[r][j].x), bflo(hw[r][j].y), bfhi(hw[r][j].y)}; s += (v[j].x * v[j].x + v[j].y * v[j].y) + (v[j].z * v[j].z + v[j].w * v[j].w); }
            const float rstd = __builtin_amdgcn_rsqf(wave_sum(s) * (1.f / DM) + RMS_EPS);
            f32x4* xr = (f32x4*)(F.out + (size_t)mm * DM) + F.lane;
#pragma unroll
            for (int j = 0; j < 8; ++j) xr[64 * j] = v[j] * rstd * gg[j]; } }
    }
}

constexpr int NPHASE = 15;
__global__ void __launch_bounds__(512, 2) fwd_kernel(Args args) {
    extern __shared__ __attribute__((aligned(16))) unsigned char lds_raw[];
    Frame F;
    F.lds = (LAS unsigned char*)lds_raw; F.ws = args.ws; F.in = args.in; F.out = args.out;
    F.tid = threadIdx.x; F.lane = F.tid & 63; F.wave = __builtin_amdgcn_readfirstlane(F.tid >> 6);
    F.G = gridDim.x; { const int bx = blockIdx.x; F.vcu = (F.G % 8 == 0) ? (bx % 8) * (F.G / 8) + bx / 8 : bx; }
    F.gw = F.vcu * 8 + F.wave; F.NGW = F.G * 8;
    unsigned char* ws = args.ws;
    volatile LAS unsigned* MISCW = (volatile LAS unsigned*)(F.lds + LDSCTL_OFF);
    if (F.tid < 64) MISCW[F.tid] = 0u;
    __syncthreads();
    const int lo = args.ph_lo, hi = args.ph_hi;
    XcdBarrier bar; bar.bar = (unsigned*)(ws + WS_CTL) + CW_BAR; bar.x = 0; bar.st = nullptr;
    if (hi - lo > 1) bar = xcd_barrier_post((unsigned*)(ws + WS_CTL) + CW_BAR, MISCW + 8);
#ifdef ONLY_PHASE
#define IN(k) ((k) == ONLY_PHASE && lo <= (k) && (k) < hi)
#else
#define IN(k) (lo <= (k) && (k) < hi)
#endif
#define SEAM(k) do { if (IN(k) && IN((k) + 1)) xcd_barrier(bar); } while (0)
    using namespace pg8;
    LAS unsigned char* lds = F.lds;
    const int G = F.G, bx = (int)blockIdx.x;

    if (IN(0)) { p0_prologue(F); } SEAM(0);
    if (IN(1)) {
        { SchedDense S{ws + WS_U, 2048, ws + WS_W1, 2048, 32, 64, ZLD / 256, G, bx, 2, 0};
          EpiZ E{(bf16*)(ws + WS_Z), (unsigned*)(ws + WS_CTL) + CW_QKN};
          gemm_phase(lds, S, E); }
        {
          SchedDenseRange S{{ws + WS_U8E, 2048, ws + WS_W1G8, 2048, 16, 64, GLD / 256, G, bx, 1, 0x79797979}, bx < 128 ? 640 + bx * 3 : (bx - 128) * 5, bx < 128 ? 3 : 5};
          EpiGate E{ws + WS_GATES};
          gemm_phase<EpiGate, SchedDenseRange, true>(lds, S, E); }
    } SEAM(1);
    if (IN(2)) { p2_shift(F); } SEAM(2);
    if (IN(3)) {
#ifndef NO_LORA
        { SchedLora S{(const bf16*)(ws + WS_AP), (const bf16*)(ws + WS_WL), 0, 8, G, F.vcu, 256};
          EpiLoraW E{(bf16*)(ws + WS_WD), F.in[12]};
          gemm_phase(lds, S, E); }
        { SchedLora S{(const bf16*)(ws + WS_AP), (const bf16*)(ws + WS_WL), 8, 8, G, F.vcu, 256};
          EpiLoraA E{(bf16*)(ws + WS_KT), (bf16*)(ws + WS_BV), (const bf16*)(ws + WS_KS), (const bf16*)(ws + WS_KK), F.in[14], F.in[18]};
          gemm_phase(lds, S, E); }
        { SchedLora S{(const bf16*)(ws + WS_AP), (const bf16*)(ws + WS_WL), 16, 4, G, F.vcu, 256};
          EpiLoraG E{(bf16*)(ws + WS_G)};
          gemm_phase(lds, S, E); }
#endif
        __syncthreads();
#ifndef NO_ATTN
        attn_phase(F);
#endif
    } SEAM(3);
    if (IN(4)) { scan_phase<true>(F); } SEAM(4);
    if (IN(5)) { p5_post(F); } SEAM(5);
    if (IN(6)) {
        SchedPair S{(const bf16*)(ws + WS_YA), (const bf16*)(ws + WS_YR), 1024, 1024, (const bf16*)(ws + WS_WBR), (const bf16*)(ws + WS_WBR) + (size_t)2048 * 1024, 1024, 16, 16, 64, 8, G, bx};
        EpiMerge E{(bf16*)(ws + WS_MERGED), ws + WS_GATES};
        gemm_phase(lds, S, E);
    } SEAM(6);
    if (IN(7)) {
        SchedDense S{ws + WS_MERGED, 2048, ws + WS_WOUT, 2048, 32, 64, 8, G, bx, 2, 0};
        EpiResF32 E{(bf16*)(ws + WS_HRES), F.in[0]};
        gemm_phase(lds, S, E);
    } SEAM(7);
    if (IN(8)) { p8_route(F); } SEAM(8);
    if (IN(9)) { p10_slots(F); } SEAM(9);
    if (IN(10)) {
        SchedMoeUp S{ws + WS_U, ws + WS_WUP, (const int*)(ws + WS_SLOT_TOK), (const int*)(ws + WS_MISC), G, F.vcu, 2048, 0x79797979};
        EpiUp E{ws + WS_HB};
        gemm_phase<EpiUp, SchedMoeUp, true>(lds, S, E);
        { const int ntl = ((const int*)(ws + WS_MISC))[MI_NT] * 4, rem = ntl % G, nshort = rem ? G - rem : G;
          SchedStride S2{{ws + WS_PB, 256, ws + WS_WPP, 2048, 4, 64, 8, G, F.vcu, 2, 0}, rem ? F.vcu - rem : F.vcu, nshort};
          EpiP E2{ws + WS_PBUF};
          gemm_phase(lds, S2, E2); }
    } SEAM(10);
    if (IN(11)) {
        SchedMoeDown S{ws + WS_HB, ws + WS_WDN, (const int*)(ws + WS_MISC), G, F.vcu, 512, 0x7A7A7A7A};
        EpiDown E{ws + WS_Y, (const int*)(ws + WS_SLOT_DST), (const float*)(ws + WS_SLOT_G)};
        gemm_phase<EpiDown, SchedMoeDown, true>(lds, S, E);
    } SEAM(11);
    if (IN(12)) { combine_phase(F); } SEAM(12);
    if (IN(13)) {
        { SchedDense S{ws + WS_U, 2048, ws + WS_WPG, 2048, 16, 64, 8, G, bx, 1, 0x79797979};
          EpiPleG E{ws + WS_PBUF, (bf16*)(ws + WS_HRES)};
          gemm_phase<EpiPleG, SchedDense, true>(lds, S, E); }
    } SEAM(13);
    if (IN(14)) { final_phase(F); }
#undef IN
#undef SEAM
}

extern "C" void kernel_launch(void* const* d_in, const int* in_sizes, int n_in, void* d_out, int out_size, void* d_ws, size_t ws_size, hipStream_t stream) {
    static int grid = 0;
    if (grid == 0) {
        if (n_in != 38 || out_size != NTOK * DM || ws_size < WS_END) { fprintf(stderr, "kernel_launch: unexpected problem (n_in %d, out %d, ws %zu)\n", n_in, out_size, ws_size); grid = -1; return; }
        if (hipFuncSetAttribute((const void*)fwd_kernel, hipFuncAttributeMaxDynamicSharedMemorySize, LDS_BYTES) != hipSuccess) { fprintf(stderr, "kernel_launch: hipFuncSetAttribute failed\n"); grid = -1; return; }
        int dev = 0, cus = 0, per_cu = 0;
        (void)hipGetDevice(&dev); (void)hipDeviceGetAttribute(&cus, hipDeviceAttributeMultiprocessorCount, dev);
        (void)hipOccupancyMaxActiveBlocksPerMultiprocessor(&per_cu, (const void*)fwd_kernel, 512, LDS_BYTES);
        (void)hipGetLastError();
        if (per_cu < 1 || cus < 256) fprintf(stderr, "kernel_launch: note: occupancy %d blocks/CU, %d CUs\n", per_cu, cus);
        grid = 256;
    }
    if (grid < 0) return;
    (void)hipMemsetAsync((char*)d_ws + WS_CTL, 0, CTL_BYTES, stream);
    Args a{};
    for (int i = 0; i < 38; ++i) a.in[i] = (const float*)d_in[i];
    a.out = (float*)d_out; a.ws = (unsigned char*)d_ws;
#if MK_ONE_LAUNCH
    a.ph_lo = 0; a.ph_hi = NPHASE;
    hipLaunchKernelGGL(fwd_kernel, dim3(grid), dim3(512), LDS_BYTES, stream, a);
#else
    for (int p = 0; p < NPHASE; ++p) { a.ph_lo = p; a.ph_hi = p + 1; hipLaunchKernelGGL(fwd_kernel, dim3(grid), dim3(512), LDS_BYTES, stream, a); }
#endif
}
```

```cpp
#include <hip/hip_runtime.h>
#include <cstdio>
#include <cstdint>

#ifndef MK_ONE_LAUNCH
#define MK_ONE_LAUNCH 1
#endif

#define GAS __attribute__((address_space(1)))
#define LAS __attribute__((address_space(3)))
typedef unsigned short bf16;
typedef short bf16x8 __attribute__((ext_vector_type(8)));
typedef float f32x2 __attribute__((ext_vector_type(2)));
typedef float f32x4 __attribute__((ext_vector_type(4)));
typedef float f32x16 __attribute__((ext_vector_type(16)));
typedef unsigned u32x2 __attribute__((ext_vector_type(2)));
typedef unsigned u32x4 __attribute__((ext_vector_type(4)));

constexpr int NTOK = 16384, DM = 2048, SEQ = 2048, NB = 8;
constexpr int ZLD = 6656;
constexpr int ZR = 3072;
constexpr int RC = 3488;
constexpr int GLD = 4096;
constexpr int N1 = ZLD + GLD;
constexpr int NEXP = 64, TOPK = 8, EFF = 512;
constexpr int RCAP = 147456;
constexpr int SLOTS = RCAP + NTOK;
constexpr float RMS_EPS = 1e-6f, GN_EPS = 64e-5f;
constexpr float LOG2E = 1.4426950408889634f;

constexpr size_t MiB = 1u << 20;
constexpr size_t WS_CTL = 0, CTL_BYTES = 1 * MiB;
constexpr size_t WS_TOPI = 1 * MiB, WS_TOPG = WS_TOPI + 512 * 1024, WS_WGCNT = 2 * MiB, WS_MISC = WS_WGCNT + 64 * 1024;
constexpr size_t WS_SLOT_TOK = 3 * MiB, WS_SLOT_DST = 4 * MiB, WS_SLOT_G = 5 * MiB;
constexpr size_t WS_WRT = 7 * MiB, WS_WL = 8 * MiB, WL_BYTES = 5120 * 256 * 2;
constexpr size_t WS_PB = 11 * MiB, WS_WPP = 19 * MiB, WS_WPG = 27 * MiB, WS_WOUT = 35 * MiB, WS_WBR = 43 * MiB, WS_W1 = 51 * MiB;
constexpr size_t WS_Z = 93 * MiB, WS_U = 301 * MiB;
constexpr size_t WS_WUP = 93 * MiB, WS_WDN = 223 * MiB, WS_YR = 288 * MiB;
constexpr size_t WS_GATES = 365 * MiB, WS_YA = 493 * MiB, WS_R = 525 * MiB, WS_V = 557 * MiB, WS_KK = 589 * MiB, WS_WD = 621 * MiB, WS_KT = 749 * MiB, WS_BV = 813 * MiB, WS_G = 877 * MiB;
constexpr size_t WS_KS = 909 * MiB, WS_AP = 941 * MiB, WS_VT = 957 * MiB;
constexpr size_t WS_YS = 909 * MiB, WS_MERGED = 621 * MiB;
constexpr size_t WS_HRES = 877 * MiB  , WS_HB = 365 * MiB, WS_Y = 445 * MiB  , WS_PBUF = 749 * MiB;
constexpr size_t WS_END = 1037 * MiB;
constexpr size_t WS_W1G8 = WS_W1 + (size_t)ZLD * 2048 * 2;
constexpr size_t WS_U8E = WS_R;
constexpr int MI_TOTAL = 0, MI_PADDED = 64, MI_PSTART = 128, MI_NT = 192, MI_TILE_E = 1024, MI_TILE_R0 = 2048;
constexpr int CW_BAR = 4096, CW_QKN = 1024;

constexpr int RING_BYTES = 131072, LDSCTL_OFF = 143360, LDS_BYTES = 147456;

__device__ __forceinline__ unsigned cvt_pk_bf16(float lo, float hi) { unsigned r; asm("v_cvt_pk_bf16_f32 %0, %1, %2" : "=v"(r) : "v"(lo), "v"(hi)); return r; }
typedef __bf16 bf16x2v __attribute__((ext_vector_type(2)));
__device__ __forceinline__ unsigned cvt_pk_bf16_hz(float lo, float hi) { return __builtin_bit_cast(unsigned, __builtin_convertvector((f32x2){lo, hi}, bf16x2v)); }
__device__ __forceinline__ float bflo(unsigned w) { return __builtin_bit_cast(float, w << 16); }
__device__ __forceinline__ float bfhi(unsigned w) { return __builtin_bit_cast(float, w & 0xffff0000u); }
__device__ __forceinline__ float ex2(float x) { return __builtin_amdgcn_exp2f(x); }
__device__ __forceinline__ float sigm(float x) { return __builtin_amdgcn_rcpf(1.0f + ex2(-x * LOG2E)); }
constexpr int DPP_X1 = 0xB1, DPP_X2 = 0x4E, DPP_HM = 0x141, DPP_RM = 0x140;
template <int CTRL> __device__ __forceinline__ float dppf(float x) { return __builtin_bit_cast(float, __builtin_amdgcn_update_dpp(0, __builtin_bit_cast(int, x), CTRL, 0xf, 0xf, false)); }
template <int CTRL> __device__ __forceinline__ int dppi(int x) { return __builtin_amdgcn_update_dpp(0, x, CTRL, 0xf, 0xf, false); }
__device__ __forceinline__ float quad_sum(float v) { v += dppf<DPP_X1>(v); v += dppf<DPP_X2>(v); return v; }
__device__ __forceinline__ float row16_sum(float v) { v += dppf<DPP_X1>(v); v += dppf<DPP_X2>(v); v += dppf<DPP_HM>(v); v += dppf<DPP_RM>(v); return v; }
__device__ __forceinline__ float row16_max(float v) { v = fmaxf(v, dppf<DPP_X1>(v)); v = fmaxf(v, dppf<DPP_X2>(v)); v = fmaxf(v, dppf<DPP_HM>(v)); v = fmaxf(v, dppf<DPP_RM>(v)); return v; }
__device__ __forceinline__ float wave_sum(float v) { v = row16_sum(v); v += __shfl_xor(v, 16); v += __shfl_xor(v, 32); return v; }
__device__ __forceinline__ void unpack8(const u32x4 w, float (&f)[8]) { f[0] = bflo(w.x); f[1] = bfhi(w.x); f[2] = bflo(w.y); f[3] = bfhi(w.y); f[4] = bflo(w.z); f[5] = bfhi(w.z); f[6] = bflo(w.w); f[7] = bfhi(w.w); }
__device__ __forceinline__ u32x4 pack8(const float (&f)[8]) { u32x4 w; w.x = cvt_pk_bf16(f[0], f[1]); w.y = cvt_pk_bf16(f[2], f[3]); w.z = cvt_pk_bf16(f[4], f[5]); w.w = cvt_pk_bf16(f[6], f[7]); return w; }
#define dpp_f(v, ctrl) __builtin_bit_cast(float, __builtin_amdgcn_update_dpp(__builtin_bit_cast(int, (v)), __builtin_bit_cast(int, (v)), (ctrl), 0xF, 0xF, true))
#define PIN(x) asm("" : "+v"(x))
__device__ __forceinline__ void fmac_(float& acc, float a, float b) { asm("v_fmac_f32 %0, %1, %2" : "+v"(acc) : "v"(a), "v"(b)); }
__device__ __forceinline__ float fmul_(float a, float b) { float r; asm("v_mul_f32 %0, %1, %2" : "=v"(r) : "v"(a), "v"(b)); return r; }
__device__ __forceinline__ float fma3_(float a, float b, float c) { float r; asm("v_fma_f32 %0, %1, %2, %3" : "=v"(r) : "v"(a), "v"(b), "v"(c)); return r; }
__device__ __forceinline__ unsigned pk4_fp8(float a, float b, float c, float d) { int w = 0; w = __builtin_amdgcn_cvt_pk_fp8_f32(a, b, w, false); w = __builtin_amdgcn_cvt_pk_fp8_f32(c, d, w, true); return (unsigned)w; }
#define LDS_WAIT() asm volatile("s_waitcnt lgkmcnt(0)" ::: "memory")
#define VM_WAIT() asm volatile("s_waitcnt vmcnt(0)" ::: "memory")

#define XB_TMO      128
#define XB_XCNT(j)  (256  + 64 * (j))
#define XB_XSUB(j)  (1280 + 64 * (j))
#define XB_XGEN(j)  (2304 + 64 * (j))
#define XB_TOP      3328
#define XB_TOPGEN   3392
#define XCD_BAR_WORDS 3456
#define XB_SPIN_CAP (1u << 22)
__device__ __forceinline__ unsigned xb_ld(unsigned* p)              { return __hip_atomic_load(p, __ATOMIC_RELAXED, __HIP_MEMORY_SCOPE_AGENT); }
__device__ __forceinline__ unsigned xb_add(unsigned* p, unsigned v) { return __hip_atomic_fetch_add(p, v, __ATOMIC_RELAXED, __HIP_MEMORY_SCOPE_AGENT); }
__device__ __forceinline__ unsigned xb_xcc_id() { return (unsigned)__builtin_amdgcn_s_getreg((3 << 11) | 20) & 0xFu; }
#define XB_SPIN(cond, bar) do { unsigned _sp = 0; while (cond) { __builtin_amdgcn_s_sleep(1); \
    if ((++_sp & 255u) == 0u) { if (xb_ld(&(bar)[XB_TMO])) break; if (_sp > XB_SPIN_CAP) { atomicAdd(&(bar)[XB_TMO], 1u); break; } } } } while (0)
struct XcdBarrier { unsigned* bar; unsigned x; volatile LAS unsigned* st; };
__device__ __forceinline__ XcdBarrier xcd_barrier_post(unsigned* bar, volatile LAS unsigned* st) {
    XcdBarrier b; b.bar = bar; b.x = xb_xcc_id(); b.st = st;
    if (threadIdx.x == 0) (void)xb_add(&bar[XB_XCNT(b.x)], 1u);
    return b;
}
__device__ __forceinline__ void xcd_barrier_complete(unsigned* bar, unsigned x, unsigned& nloc, unsigned& nx) {
    const unsigned G = gridDim.x * gridDim.y * gridDim.z;
    unsigned sum, cnt, mine, sp = 0u;
    for (;;) {
        sum = 0u; cnt = 0u; mine = 0u;
#pragma unroll
        for (unsigned j = 0; j < 16; ++j) { const unsigned c = xb_ld(&bar[XB_XCNT(j)]); sum += c; cnt += (c > 0u) ? 1u : 0u; mine = (j == x) ? c : mine; }
        if (sum == G) break;
        __builtin_amdgcn_s_sleep(1);
        if ((++sp & 255u) == 0u) { if (xb_ld(&bar[XB_TMO])) break; if (sp > XB_SPIN_CAP) { atomicAdd(&bar[XB_TMO], 1u); break; } }
    }
    nloc = mine > 0u ? mine : 1u; nx = cnt > 0u ? cnt : 1u;
}
__device__ __forceinline__ void xcd_barrier(const XcdBarrier& b) {
    asm volatile("s_waitcnt vmcnt(0)" ::: "memory");
    __syncthreads();
    if (threadIdx.x == 0) {
        unsigned* bar = b.bar;
        __builtin_amdgcn_s_waitcnt(0);
        unsigned nloc = b.st[0], nx = b.st[1];
        if (nloc == 0u) { xcd_barrier_complete(bar, b.x, nloc, nx); b.st[0] = nloc; b.st[1] = nx; }
        const unsigned old = xb_add(&bar[XB_XSUB(b.x)], 1u);
        const unsigned gen = old / nloc;
        if (old + 1u == (gen + 1u) * nloc) {
            __builtin_amdgcn_fence(__ATOMIC_RELEASE, "agent");
            asm volatile("s_waitcnt vmcnt(0)" ::: "memory");
            const unsigned og = xb_add(&bar[XB_TOP], 1u);
            const unsigned tg = og / nx;
            if (og + 1u == (tg + 1u) * nx) xb_add(&bar[XB_TOPGEN], 1u);
            else XB_SPIN(xb_ld(&bar[XB_TOPGEN]) == tg, bar);
            __builtin_amdgcn_fence(__ATOMIC_ACQUIRE, "agent");
            xb_add(&bar[XB_XGEN(b.x)], 1u);
            asm volatile("s_waitcnt vmcnt(0)" ::: "memory");
        } else {
            XB_SPIN(xb_ld(&bar[XB_XGEN(b.x)]) == gen, bar);
            __builtin_amdgcn_fence(__ATOMIC_ACQUIRE, "agent");
            asm volatile("s_waitcnt vmcnt(0)" ::: "memory");
        }
    }
    __syncthreads();
}

namespace pg8 {
constexpr int BM = 256, BK = 64, HALF = 128, HTB = HALF * BK * 2, STAGE_BYTES = 8 * HTB, NXCD = 8, WGM = 8;
__device__ __forceinline__ int lds_byte(int r, int c) { const int st = (r >> 4) * 2 + (c >> 5), rr = r & 15, cc = c & 31, ob = rr * 64 + cc * 2; return st * 1024 + (ob ^ (((ob >> 9) & 1) << 5)); }
__device__ __forceinline__ void stage_rc(int b, int& R, int& C) { const int st = b / 1024, sb = b % 1024, swz = sb ^ (((sb >> 9) & 1) << 5); R = (st >> 1) * 16 + swz / 64; C = (st & 1) * 32 + (swz % 64) / 2; }
__device__ __forceinline__ int perm32(int rho) { const int n = rho >> 4, i = rho & 15; return 8 * (i >> 2) + 4 * n + (i & 3); }
struct Unit { int pm, pn, s, x; };
__device__ __forceinline__ void static_tile(int L, int nM, int nN, int& pm, int& pn) {
    const int nwg = nM * nN; int wgid = L;
    { const int q = nwg / NXCD, r = nwg % NXCD, xcd = wgid % NXCD, off = wgid / NXCD; wgid = (xcd < r ? xcd * (q + 1) : r * (q + 1) + (xcd - r) * q) + off; }
    const int nig = WGM * nN, gid = wgid / nig, fm = gid * WGM, gsz = (nM - fm) < WGM ? (nM - fm) : WGM;
    pm = fm + ((wgid % nig) % gsz); pn = (wgid % nig) / gsz;
}
typedef int v8i __attribute__((ext_vector_type(8)));
template <class Epi, class Sched, bool FP8 = false>
__device__ __forceinline__ void gemm_phase(LAS unsigned char* lds, const Sched& S, const Epi& E) {
    int tid = threadIdx.x; asm volatile("" : "+v"(tid));
    const int wid = __builtin_amdgcn_readfirstlane(tid >> 6), lane = tid & 63, wr = wid >> 2, wc = wid & 3, fr = lane & 15, fq = lane >> 4;
    const int ldb = S.ldb;
    int RA[2]; unsigned CA2[2], voffB[2];
#pragma unroll
    for (int i = 0; i < 2; ++i) { int R, C; stage_rc(tid * 16 + i * 8192, R, C); const int Rb = (R & ~31) + perm32(R & 31);
        RA[i] = R; CA2[i] = (unsigned)C * 2u; voffB[i] = FP8 ? (unsigned)(Rb * ldb + C * 2) : (unsigned)(Rb * ldb + C) * 2u; }
    const size_t kstep = (size_t)(BK * 2);
    const size_t hstepB = FP8 ? (size_t)HALF * ldb : (size_t)HALF * ldb * 2;
    const unsigned ldsw = (unsigned)wid * 1024u;
    const int aoff = lds_byte(wr * 64 + fr, fq * 8), boff = lds_byte(wc * 32 + fr, fq * 8);
#define PG8_SA(b, h) (((b) * 2 + (h)) * HTB)
#define PG8_SB(b, h) ((4 + (b) * 2 + (h)) * HTB)
#define PG8_STAGE(bufoff, gbase, voff) do { _Pragma("unroll") for (int _i = 0; _i < 2; ++_i) \
        __builtin_amdgcn_global_load_lds((const unsigned*)((const char*)(gbase) + (voff)[_i]), (LAS unsigned*)(lds + (bufoff) + ldsw + _i * 8192), 16, 0, 0); } while (0)
#define PG8_LD8(p) __builtin_bit_cast(v8i, __builtin_shufflevector(*(const LAS u32x4*)(p), *(const LAS u32x4*)((p) + 1024), 0, 1, 2, 3, 4, 5, 6, 7))
#define PG8_LDA(dst, b, h) do { if constexpr (FP8) { _Pragma("unroll") for (int m = 0; m < 4; ++m) dst##8[m] = PG8_LD8(lds + PG8_SA(b, h) + aoff + m * 2048); } \
        else { _Pragma("unroll") for (int m = 0; m < 4; ++m) _Pragma("unroll") for (int k = 0; k < 2; ++k) dst[m][k] = *(const LAS bf16x8*)(lds + PG8_SA(b, h) + aoff + m * 2048 + k * 1024); } } while (0)
#define PG8_LDB(dst, b, h) do { if constexpr (FP8) { _Pragma("unroll") for (int n = 0; n < 2; ++n) dst##8[n] = PG8_LD8(lds + PG8_SB(b, h) + boff + n * 2048); } \
        else { _Pragma("unroll") for (int n = 0; n < 2; ++n) _Pragma("unroll") for (int k = 0; k < 2; ++k) dst[n][k] = *(const LAS bf16x8*)(lds + PG8_SB(b, h) + boff + n * 2048 + k * 1024); } } while (0)
#define PG8_MMA(ai, bj, At, Bt) do { __builtin_amdgcn_s_setprio(1); _Pragma("unroll") for (int m = 0; m < 4; ++m) _Pragma("unroll") for (int n = 0; n < 2; ++n) { \
        if constexpr (FP8) asm volatile("v_mfma_scale_f32_16x16x128_f8f6f4 %0, %1, %2, %0, %3, %4 op_sel_hi:[0,0,0]" : "+v"(acc[ai][bj][m][n]) : "v"(Bt##8[n]), "v"(At##8[m]), "v"(wscale), "v"(ascale)); \
        else { _Pragma("unroll") for (int k = 0; k < 2; ++k) acc[ai][bj][m][n] = __builtin_amdgcn_mfma_f32_16x16x32_bf16(Bt[n][k], At[m][k], acc[ai][bj][m][n], 0, 0, 0); } } __builtin_amdgcn_s_setprio(0); } while (0)
#define PG8_WAIT_V(n) asm volatile("s_waitcnt vmcnt(" #n ")" ::: "memory")
#define PG8_WAIT_L(n) asm volatile("s_waitcnt lgkmcnt(" #n ")" ::: "memory")
#define PG8_BAR __builtin_amdgcn_s_barrier()
#define PG8_SCHED __builtin_amdgcn_sched_barrier(0)
    Unit cur, nxt; int ui = 0;
    if (!S.next(0, cur)) return;
    int wscale = 0x7F7F7F7F, ascale = 0x7F7F7F7F; if constexpr (FP8) wscale = S.wscale;
    f32x4 acc[2][2][4][2];
#pragma unroll
    for (int a = 0; a < 2; ++a)
#pragma unroll
        for (int b = 0; b < 2; ++b)
#pragma unroll
            for (int m = 0; m < 4; ++m)
#pragma unroll
                for (int n = 0; n < 2; ++n) acc[a][b][m][n] = (f32x4){0.f, 0.f, 0.f, 0.f};
    bf16x8 At[4][2], B0[2][2], B1[2][2]; v8i At8[4], B08[2], B18[2];
    unsigned vC[2][2], vN[2][2];
#pragma unroll
    for (int h = 0; h < 2; ++h)
#pragma unroll
        for (int i = 0; i < 2; ++i) vC[h][i] = S.arow(cur, h * HALF + RA[i]) + CA2[i];
    const char* cA = S.aptr(cur); const char* cB = S.bptr(cur);
    PG8_STAGE(PG8_SB(0, 0), cB, voffB); PG8_STAGE(PG8_SB(0, 1), cB + hstepB, voffB); PG8_STAGE(PG8_SA(0, 0), cA, vC[0]); PG8_STAGE(PG8_SA(0, 1), cA, vC[1]);
    if (wr == 1) PG8_BAR;
    PG8_WAIT_V(2); PG8_BAR;
    PG8_STAGE(PG8_SB(1, 0), cB + kstep, voffB); PG8_STAGE(PG8_SA(1, 0), cA + kstep, vC[0]); PG8_STAGE(PG8_SB(1, 1), cB + hstepB + kstep, voffB);
    PG8_WAIT_V(6); PG8_BAR;
    for (;;) {
        const bool has_next = S.next(ui + 1, nxt);
        const char* nA = cA; const char* nB = cB;
        if constexpr (Sched::VARROW) {
#pragma unroll
            for (int h = 0; h < 2; ++h)
#pragma unroll
                for (int i = 0; i < 2; ++i) vN[h][i] = vC[h][i]; }
        if (has_next) { nA = S.aptr(nxt); nB = S.bptr(nxt);
            if constexpr (Sched::VARROW) {
#pragma unroll
                for (int h = 0; h < 2; ++h)
#pragma unroll
                    for (int i = 0; i < 2; ++i) vN[h][i] = S.arow(nxt, h * HALF + RA[i]) + CA2[i]; } }
        const int nt = S.nt(cur);
#pragma nounroll
        for (int t = 0; t < nt; t += 2) {
            const bool last = (t == nt - 2);
            const char* a1 = cA + (size_t)(t + 1) * kstep;
            const char* a2 = last ? nA : cA + (size_t)(t + 2) * kstep; const char* b2 = last ? nB : cB + (size_t)(t + 2) * kstep;
            const char* a3 = a2 + kstep; const char* b3 = b2 + kstep;
            unsigned v2[2][2];
#pragma unroll
            for (int h = 0; h < 2; ++h)
#pragma unroll
                for (int i = 0; i < 2; ++i) { if constexpr (Sched::VARROW) v2[h][i] = last ? vN[h][i] : vC[h][i]; else v2[h][i] = vC[h][i]; }
            PG8_LDB(B0, 0, 0); PG8_LDB(B1, 0, 1); PG8_SCHED; PG8_LDA(At, 0, 0); PG8_STAGE(PG8_SA(1, 1), a1, vC[1]);
            PG8_WAIT_V(8); PG8_WAIT_L(0); PG8_BAR; PG8_MMA(0, 0, At, B0); PG8_MMA(0, 1, At, B1); PG8_BAR; PG8_SCHED;
            PG8_LDA(At, 0, 1); PG8_STAGE(PG8_SB(0, 0), b2, voffB); PG8_STAGE(PG8_SB(0, 1), b2 + hstepB, voffB); PG8_STAGE(PG8_SA(0, 0), a2, v2[0]);
            PG8_WAIT_V(8); PG8_WAIT_L(0); PG8_BAR; PG8_MMA(1, 0, At, B0); PG8_MMA(1, 1, At, B1); PG8_BAR; PG8_SCHED;
            PG8_LDB(B0, 1, 0); PG8_LDB(B1, 1, 1); PG8_SCHED; PG8_LDA(At, 1, 0); PG8_STAGE(PG8_SA(0, 1), a2, v2[1]);
            PG8_WAIT_V(8); PG8_WAIT_L(0); PG8_BAR; PG8_MMA(0, 0, At, B0); PG8_MMA(0, 1, At, B1); PG8_BAR; PG8_SCHED;
            PG8_LDA(At, 1, 1); PG8_STAGE(PG8_SB(1, 0), b3, voffB); PG8_STAGE(PG8_SB(1, 1), b3 + hstepB, voffB); PG8_STAGE(PG8_SA(1, 0), a3, v2[0]);
            PG8_WAIT_V(8); PG8_WAIT_L(0); PG8_BAR; PG8_MMA(1, 0, At, B0); PG8_MMA(1, 1, At, B1); PG8_BAR; PG8_SCHED;
        }
        if (wr == 0) PG8_BAR;
        if constexpr (FP8) asm volatile("s_nop 15\n\ts_nop 15\n\ts_nop 15\n\ts_nop 15\n\ts_nop 15\n\ts_nop 15" ::: "memory");
        E(acc, cur, wr, wc, fr, fq);
        if (!has_next) break;
#pragma unroll
        for (int a = 0; a < 2; ++a)
#pragma unroll
            for (int b = 0; b < 2; ++b)
#pragma unroll
                for (int m = 0; m < 4; ++m)
#pragma unroll
                    for (int n = 0; n < 2; ++n) acc[a][b][m][n] = (f32x4){0.f, 0.f, 0.f, 0.f};
        cur = nxt; cA = nA; cB = nB; ++ui;
        if constexpr (Sched::VARROW) {
#pragma unroll
            for (int h = 0; h < 2; ++h)
#pragma unroll
                for (int i = 0; i < 2; ++i) vC[h][i] = vN[h][i]; }
        if (wr == 1) PG8_BAR;
    }
    PG8_WAIT_V(0);
    PG8_BAR;
#undef PG8_SA
#undef PG8_SB
#undef PG8_STAGE
#undef PG8_LDA
#undef PG8_LDB
#undef PG8_MMA
#undef PG8_LD8
#undef PG8_WAIT_V
#undef PG8_WAIT_L
#undef PG8_BAR
#undef PG8_SCHED
}

struct SchedDense {
    static constexpr bool VARROW = false;
    const void* A; int lda; const void* Bt; int ldb; int ntk; int nM, nN, G, c; int esz; int wscale;
    __device__ __forceinline__ bool next(int i, Unit& u) const { const int L = i * G + c; if (L >= nM * nN) return false; static_tile(L, nM, nN, u.pm, u.pn); u.s = 0; u.x = 0; return true; }
    __device__ __forceinline__ int nt(const Unit&) const { return ntk; }
    __device__ __forceinline__ const char* aptr(const Unit& u) const { return (const char*)A + (size_t)u.pm * BM * lda * esz; }
    __device__ __forceinline__ unsigned arow(const Unit&, int r) const { return (unsigned)(r * lda * esz); }
    __device__ __forceinline__ const char* bptr(const Unit& u) const { return (const char*)Bt + (size_t)u.pn * BM * ldb * esz; }
};
struct SchedDenseRange : SchedDense {
    int base, cnt;
    __device__ __forceinline__ bool next(int i, Unit& u) const { if (i >= cnt) return false; static_tile(base + i, nM, nN, u.pm, u.pn); u.s = 0; u.x = 0; return true; }
};
struct SchedStride : SchedDense {
    int first, stride;
    __device__ __forceinline__ bool next(int i, Unit& u) const { const int L = first + i * stride; if (first < 0 || L >= nM * nN) return false; u.pm = L / nN; u.pn = L % nN; u.s = 0; u.x = 0; return true; }
};
struct SchedPair {
    static constexpr bool VARROW = true;
    const bf16* A0; const bf16* A1; int lda0, lda1; const bf16* B0; const bf16* B1; int ldb; int nt0, nt1; int nM, nN, G, c;
    __device__ __forceinline__ bool next(int i, Unit& u) const { const int L = (i >> 1) * G + c; if (L >= nM * nN) return false; static_tile(L, nM, nN, u.pm, u.pn); u.s = i & 1; u.x = 0; return true; }
    __device__ __forceinline__ int nt(const Unit& u) const { return u.s ? nt1 : nt0; }
    __device__ __forceinline__ const char* aptr(const Unit& u) const { return u.s ? (const char*)A1 + (size_t)u.pm * BM * lda1 * 2 : (const char*)A0 + (size_t)u.pm * BM * lda0 * 2; }
    __device__ __forceinline__ unsigned arow(const Unit& u, int r) const { return (unsigned)(r * (u.s ? lda1 : lda0) * 2); }
    __device__ __forceinline__ const char* bptr(const Unit& u) const { return (const char*)(u.s ? B1 : B0) + (size_t)u.pn * BM * ldb * 2; }
};
struct SchedLora {
    static constexpr bool VARROW = false;
    const bf16* A; const bf16* Bt; int pn0, npn; int G, c;
    int ldb;
    __device__ __forceinline__ bool next(int i, Unit& u) const { const int L = i * G + c; if (L >= 64 * npn) return false; u.pm = L / npn; u.pn = pn0 + L % npn; u.s = 0; u.x = 0; return true; }
    __device__ __forceinline__ int nt(const Unit&) const { return 4; }
    __device__ __forceinline__ const char* aptr(const Unit& u) const { return (const char*)A + (size_t)u.pm * BM * 512 * 2 + (u.pn >= 16 ? 512 : 0); }
    __device__ __forceinline__ unsigned arow(const Unit&, int r) const { return (unsigned)(r * 1024); }
    __device__ __forceinline__ const char* bptr(const Unit& u) const { return (const char*)Bt + (size_t)u.pn * BM * 256 * 2; }
};
struct SchedMoeUp {
    static constexpr bool VARROW = true;
    const unsigned char* U; const unsigned char* Wup; const int* slot_tok; const int* misc; int G, c; int ldb; int wscale;
    __device__ __forceinline__ bool next(int i, Unit& u) const { const int L = i * G + c; const int nt_ = misc[MI_NT]; if (L >= nt_ * 4) return false; u.pm = L >> 2; u.pn = L & 3; u.x = misc[MI_TILE_E + u.pm]; u.s = misc[MI_TILE_R0 + u.pm]; return true; }
    __device__ __forceinline__ int nt(const Unit&) const { return 16; }
    __device__ __forceinline__ const char* aptr(const Unit&) const { return (const char*)U; }
    __device__ __forceinline__ unsigned arow(const Unit& u, int r) const { return (unsigned)slot_tok[u.s + r] * 2048u; }
    __device__ __forceinline__ const char* bptr(const Unit& u) const { return (const char*)Wup + ((size_t)u.x * 1024 + (size_t)u.pn * 256) * 2048; }
};
struct SchedMoeDown {
    static constexpr bool VARROW = false;
    const unsigned char* H; const unsigned char* Wdn; const int* misc; int G, c; int ldb; int wscale;
    __device__ __forceinline__ bool next(int i, Unit& u) const { const int L = i * G + c; const int nt_ = misc[MI_NT]; if (L >= nt_ * 8) return false; u.pm = L >> 3; u.pn = L & 7; u.x = misc[MI_TILE_E + u.pm]; u.s = misc[MI_TILE_R0 + u.pm]; return true; }
    __device__ __forceinline__ int nt(const Unit&) const { return 4; }
    __device__ __forceinline__ const char* aptr(const Unit& u) const { return (const char*)H + (size_t)u.s * 512; }
    __device__ __forceinline__ unsigned arow(const Unit&, int r) const { return (unsigned)(r * 512); }
    __device__ __forceinline__ const char* bptr(const Unit& u) const { return (const char*)Wdn + ((size_t)u.x * 2048 + (size_t)u.pn * 256) * 512; }
};

#define EPI_ROWS_BEGIN _Pragma("unroll") for (int ai = 0; ai < 2; ++ai) _Pragma("unroll") for (int m = 0; m < 4; ++m) { const int rl = ai * HALF + wr * 64 + m * 16 + fr;
#define EPI_ROWS_END }
#define EPI_HROWS_BEGIN _Pragma("unroll") for (int m = 0; m < 4; ++m) { const int rl = ai * HALF + wr * 64 + m * 16 + fr;
struct EpiZ {
    bf16* Z; unsigned* QKN;
    __device__ __forceinline__ void operator()(const f32x4 (&acc)[2][2][4][2], const Unit& u, int wr, int wc, int fr, int fq) const {
        const int cl = u.pn * BM + wc * 32 + 8 * fq;
        EPI_ROWS_BEGIN
            bf16* rowp = Z + ((size_t)u.pm * BM + rl) * ZLD + cl;
#pragma unroll
            for (int bj = 0; bj < 2; ++bj) { const f32x4 v0 = acc[ai][bj][m][0], v1 = acc[ai][bj][m][1];
                u32x4 w; w.x = cvt_pk_bf16_hz(v0[0], v0[1]); w.y = cvt_pk_bf16_hz(v0[2], v0[3]); w.z = cvt_pk_bf16_hz(v1[0], v1[1]); w.w = cvt_pk_bf16_hz(v1[2], v1[3]);
                *(u32x4*)(rowp + bj * HALF) = w; }
        EPI_ROWS_END
        if (u.pn < 8) {
#pragma unroll
            for (int bj = 0; bj < 2; ++bj) { float nm = 0.f;
                EPI_ROWS_BEGIN
                    const f32x4 v0 = acc[ai][bj][m][0], v1 = acc[ai][bj][m][1];
                    float ss = v0[0] * v0[0] + v0[1] * v0[1] + v0[2] * v0[2] + v0[3] * v0[3] + v1[0] * v1[0] + v1[1] * v1[1] + v1[2] * v1[2] + v1[3] * v1[3];
                    ss += __shfl_xor(ss, 16); ss += __shfl_xor(ss, 32); nm = fmaxf(nm, ss); (void)rl;
                EPI_ROWS_END
                nm = row16_max(nm);
                if (fr == 0 && fq == 0) atomicMax(QKN + (u.pm >> 3) * 64 + ((u.pn * BM + wc * 32 + bj * HALF) >> 5), __float_as_uint(nm)); }
        }
    }
};
__device__ __forceinline__ unsigned pk4_u8(float a, float b, float c, float d) {
    return (unsigned)(a * 255.0f + 0.5f) | ((unsigned)(b * 255.0f + 0.5f) << 8) | ((unsigned)(c * 255.0f + 0.5f) << 16) | ((unsigned)(d * 255.0f + 0.5f) << 24); }
struct EpiGate {
    unsigned char* GT;
    __device__ __forceinline__ void operator()(const f32x4 (&acc)[2][2][4][2], const Unit& u, int wr, int wc, int fr, int fq) const {
        const int cl = u.pn * BM + wc * 32 + 8 * fq;
        EPI_ROWS_BEGIN
            unsigned char* rowp = GT + ((size_t)u.pm * BM + rl) * GLD + cl;
#pragma unroll
            for (int bj = 0; bj < 2; ++bj) { f32x4 v0 = acc[ai][bj][m][0], v1 = acc[ai][bj][m][1];
#pragma unroll
                for (int j = 0; j < 4; ++j) { v0[j] = sigm(v0[j]); v1[j] = sigm(v1[j]); }
                u32x2 w; w.x = pk4_u8(v0[0], v0[1], v0[2], v0[3]); w.y = pk4_u8(v1[0], v1[1], v1[2], v1[3]);
                *(u32x2*)(rowp + bj * HALF) = w; }
        EPI_ROWS_END
    }
};
struct EpiLoraW {
    bf16* DD; const float* w0;
    __device__ __forceinline__ void operator()(const f32x4 (&acc)[2][2][4][2], const Unit& u, int wr, int wc, int fr, int fq) const {
        const int d = (u.pn >> 2) & 1, cb = (u.pn & 3) * BM + wc * 32 + 8 * fq;
#pragma unroll
        for (int bj = 0; bj < 2; ++bj) { const int c = cb + bj * HALF;
            const f32x4 b0 = *(const f32x4*)(w0 + d * 1024 + c), b1 = *(const f32x4*)(w0 + d * 1024 + c + 4);
            EPI_ROWS_BEGIN
                const size_t row = (size_t)u.pm * BM + rl; f32x4 v0 = acc[ai][bj][m][0], v1 = acc[ai][bj][m][1];
#pragma unroll
                for (int j = 0; j < 4; ++j) { v0[j] = 1.0f - ex2(-0.60653065971f * LOG2E * sigm(v0[j] + b0[j])); v1[j] = 1.0f - ex2(-0.60653065971f * LOG2E * sigm(v1[j] + b1[j])); }
                u32x4 w; w.x = cvt_pk_bf16(v0[0], v0[1]); w.y = cvt_pk_bf16(v0[2], v0[3]); w.z = cvt_pk_bf16(v1[0], v1[1]); w.w = cvt_pk_bf16(v1[2], v1[3]);
                *(u32x4*)(DD + ((size_t)d * NTOK + row) * 1024 + c) = w;
            EPI_ROWS_END }
    }
};
struct EpiLoraA {
    bf16* KT; bf16* BV; const bf16* KS; const bf16* KK; const float* a0; const float* k_a;
    __device__ __forceinline__ void operator()(const f32x4 (&acc)[2][2][4][2], const Unit& u, int wr, int wc, int fr, int fq) const {
        const int d = (u.pn >> 2) & 1, cb = (u.pn & 3) * BM + wc * 32 + 8 * fq;
#pragma unroll
        for (int bj = 0; bj < 2; ++bj) { const int c = cb + bj * HALF;
            const f32x4 b0 = *(const f32x4*)(a0 + d * 1024 + c), b1 = *(const f32x4*)(a0 + d * 1024 + c + 4);
            const f32x4 ka0 = *(const f32x4*)(k_a + c), ka1 = *(const f32x4*)(k_a + c + 4);
#pragma unroll
            for (int ai = 0; ai < 2; ++ai) {
            u32x4 ksw[4], kkw[4];
            EPI_HROWS_BEGIN
                const size_t row = (size_t)u.pm * BM + rl; ksw[m] = *(const u32x4*)(KS + row * 1024 + c); kkw[m] = *(const u32x4*)(KK + row * 1024 + c);
            EPI_ROWS_END
            EPI_HROWS_BEGIN
                const size_t row = (size_t)u.pm * BM + rl; const f32x4 v0 = acc[ai][bj][m][0], v1 = acc[ai][bj][m][1];
                float kv[8], kkv[8], kt[8], bb[8];
                unpack8(ksw[m], kv); unpack8(kkw[m], kkv);
#pragma unroll
                for (int j = 0; j < 4; ++j) { const float a_0 = sigm(v0[j] + b0[j]), a_1 = sigm(v1[j] + b1[j]);
                    kt[j] = kv[j] * (1.0f + (a_0 - 1.0f) * ka0[j]); kt[4 + j] = kv[4 + j] * (1.0f + (a_1 - 1.0f) * ka1[j]);
                    bb[j] = kkv[j] * a_0; bb[4 + j] = kkv[4 + j] * a_1; }
                *(u32x4*)(KT + ((size_t)d * NTOK + row) * 1024 + c) = pack8(kt); *(u32x4*)(BV + ((size_t)d * NTOK + row) * 1024 + c) = pack8(bb);
            EPI_ROWS_END } }
    }
};
struct EpiLoraG {
    bf16* GG;
    __device__ __forceinline__ void operator()(const f32x4 (&acc)[2][2][4][2], const Unit& u, int wr, int wc, int fr, int fq) const {
        const int cb = (u.pn & 3) * BM + wc * 32 + 8 * fq;
        EPI_ROWS_BEGIN
            const size_t row = (size_t)u.pm * BM + rl;
#pragma unroll
            for (int bj = 0; bj < 2; ++bj) { const int c = cb + bj * HALF; const f32x4 v0 = acc[ai][bj][m][0], v1 = acc[ai][bj][m][1];
                u32x4 w; w.x = cvt_pk_bf16_hz(v0[0], v0[1]); w.y = cvt_pk_bf16_hz(v0[2], v0[3]); w.z = cvt_pk_bf16_hz(v1[0], v1[1]); w.w = cvt_pk_bf16_hz(v1[2], v1[3]);
                *(u32x4*)(GG + row * 1024 + c) = w; }
        EPI_ROWS_END
    }
};
struct EpiMerge {
    bf16* M; const unsigned char* GT;
    __device__ __forceinline__ void operator()(const f32x4 (&acc)[2][2][4][2], const Unit& u, int wr, int wc, int fr, int fq) const {
        const int cb = u.pn * BM + wc * 32 + 8 * fq;
#pragma unroll
        for (int ai = 0; ai < 2; ++ai) {
        u32x2 gws[1][4][2]; u32x4 pws[1][4][2];
        EPI_HROWS_BEGIN
            const size_t row = (size_t)u.pm * BM + rl;
#pragma unroll
            for (int bj = 0; bj < 2; ++bj) { const int c = cb + bj * HALF; gws[0][m][bj] = *(const u32x2*)(GT + row * GLD + u.s * 2048 + c);
                pws[0][m][bj] = u.s ? *(const u32x4*)(M + row * 2048 + c) : (u32x4){0u, 0u, 0u, 0u}; }
        EPI_ROWS_END
        EPI_HROWS_BEGIN
            const size_t row = (size_t)u.pm * BM + rl;
#pragma unroll
            for (int bj = 0; bj < 2; ++bj) { const int c = cb + bj * HALF; const f32x4 v0 = acc[ai][bj][m][0], v1 = acc[ai][bj][m][1];
                const u32x2 gw = gws[0][m][bj]; constexpr float q = 1.0f / 255.0f;
                float o[8] = {v0[0] * ((float)(gw.x & 0xffu) * q), v0[1] * ((float)((gw.x >> 8) & 0xffu) * q), v0[2] * ((float)((gw.x >> 16) & 0xffu) * q), v0[3] * ((float)(gw.x >> 24) * q),
                              v1[0] * ((float)(gw.y & 0xffu) * q), v1[1] * ((float)((gw.y >> 8) & 0xffu) * q), v1[2] * ((float)((gw.y >> 16) & 0xffu) * q), v1[3] * ((float)(gw.y >> 24) * q)};
                bf16* dst = M + row * 2048 + c;
                { const u32x4 pw = pws[0][m][bj];
                    o[0] += bflo(pw.x); o[1] += bfhi(pw.x); o[2] += bflo(pw.y); o[3] += bfhi(pw.y); o[4] += bflo(pw.z); o[5] += bfhi(pw.z); o[6] += bflo(pw.w); o[7] += bfhi(pw.w); }
                u32x4 w; w.x = cvt_pk_bf16(o[0], o[1]); w.y = cvt_pk_bf16(o[2], o[3]); w.z = cvt_pk_bf16(o[4], o[5]); w.w = cvt_pk_bf16(o[6], o[7]);
                *(u32x4*)dst = w; }
        EPI_ROWS_END
        }
    }
};
struct EpiResF32 {
    bf16* O; const float* R;
    __device__ __forceinline__ void operator()(const f32x4 (&acc)[2][2][4][2], const Unit& u, int wr, int wc, int fr, int fq) const {
        const int cb = u.pn * BM + wc * 32 + 8 * fq;
#pragma unroll
        for (int ai = 0; ai < 2; ++ai) {
#pragma unroll
          for (int bj = 0; bj < 2; ++bj) {
            f32x4 xr[4][2][2];
#pragma unroll
            for (int m = 0; m < 4; ++m)
                { const size_t o = ((size_t)u.pm * BM + ai * HALF + wr * 64 + m * 16 + fr) * 2048 + cb + bj * HALF; xr[m][bj][0] = *(const f32x4*)(R + o); xr[m][bj][1] = *(const f32x4*)(R + o + 4); }
#pragma unroll
            for (int m = 0; m < 4; ++m)
                { const size_t o = ((size_t)u.pm * BM + ai * HALF + wr * 64 + m * 16 + fr) * 2048 + cb + bj * HALF;
                    const f32x4 h0 = xr[m][bj][0] + acc[ai][bj][m][0], h1 = xr[m][bj][1] + acc[ai][bj][m][1];
                    u32x4 w; w.x = cvt_pk_bf16_hz(h0[0], h0[1]); w.y = cvt_pk_bf16_hz(h0[2], h0[3]); w.z = cvt_pk_bf16_hz(h1[0], h1[1]); w.w = cvt_pk_bf16_hz(h1[2], h1[3]);
                    *(u32x4*)(O + o) = w; }
          }
        }
    }
};
struct EpiUp {
    unsigned char* H;
    __device__ __forceinline__ void operator()(const f32x4 (&acc)[2][2][4][2], const Unit& u, int wr, int wc, int fr, int fq) const {
        const int c = u.pn * HALF + wc * 32 + 8 * fq;
        EPI_ROWS_BEGIN
            const size_t row = (size_t)u.s + rl; float o[8];
#pragma unroll
            for (int n = 0; n < 2; ++n)
#pragma unroll
                for (int j = 0; j < 4; ++j) { const float g = acc[ai][0][m][n][j]; o[4 * n + j] = g * sigm(g) * acc[ai][1][m][n][j]; }
            u32x2 w; w.x = pk4_fp8(o[0], o[1], o[2], o[3]); w.y = pk4_fp8(o[4], o[5], o[6], o[7]);
            *(u32x2*)(H + row * EFF + c) = w;
        EPI_ROWS_END
    }
};
struct EpiDown {
    unsigned char* Y; const int* slot_dst; const float* slot_g;
    __device__ __forceinline__ void operator()(const f32x4 (&acc)[2][2][4][2], const Unit& u, int wr, int wc, int fr, int fq) const {
        const int cb = u.pn * BM + wc * 32 + 8 * fq;
        int dsts[2][4]; float gsc[2][4];
        EPI_ROWS_BEGIN
            dsts[ai][m] = slot_dst[u.s + rl]; gsc[ai][m] = slot_g[u.s + rl];
        EPI_ROWS_END
        EPI_ROWS_BEGIN
            const int dst = dsts[ai][m]; const float g = gsc[ai][m] * 16.0f; (void)rl;
            if (dst >= 0) {
#pragma unroll
                for (int bj = 0; bj < 2; ++bj) { const f32x4 v0 = acc[ai][bj][m][0] * g, v1 = acc[ai][bj][m][1] * g;
                    u32x2 w; w.x = pk4_fp8(v0[0], v0[1], v0[2], v0[3]); w.y = pk4_fp8(v1[0], v1[1], v1[2], v1[3]);
                    *(u32x2*)(Y + (size_t)dst * 2048 + cb + bj * HALF) = w; } }
        EPI_ROWS_END
    }
};
struct EpiP {
    unsigned char* P;
    __device__ __forceinline__ void operator()(const f32x4 (&acc)[2][2][4][2], const Unit& u, int wr, int wc, int fr, int fq) const {
        const int cb = u.pn * BM + wc * 32 + 8 * fq;
        EPI_ROWS_BEGIN
            const size_t row = (size_t)u.pm * BM + rl;
#pragma unroll
            for (int bj = 0; bj < 2; ++bj) { const size_t o = row * 2048 + cb + bj * HALF; const f32x4 v0 = acc[ai][bj][m][0], v1 = acc[ai][bj][m][1];
                u32x2 w; w.x = pk4_fp8(v0[0], v0[1], v0[2], v0[3]); w.y = pk4_fp8(v1[0], v1[1], v1[2], v1[3]); *(u32x2*)(P + o) = w; }
        EPI_ROWS_END
    }
};
struct EpiPleG {
    const unsigned char* P; bf16* O;
    __device__ __forceinline__ void operator()(const f32x4 (&acc)[2][2][4][2], const Unit& u, int wr, int wc, int fr0, int fq) const {
        int fr = fr0; asm volatile("" : "+v"(fr));
        const int cb = u.pn * BM + wc * 32 + 8 * fq;
#pragma unroll
        for (int ai = 0; ai < 2; ++ai)
#pragma unroll
          for (int bj = 0; bj < 2; ++bj) {
            u32x2 pws[4]; u32x4 hws[4];
            EPI_HROWS_BEGIN
                const size_t o = ((size_t)u.pm * BM + rl) * 2048 + cb + bj * HALF; pws[m] = *(const u32x2*)(P + o); hws[m] = *(const u32x4*)(O + o);
            EPI_ROWS_END
            EPI_HROWS_BEGIN
                const size_t o = ((size_t)u.pm * BM + rl) * 2048 + cb + bj * HALF; const f32x4 v0 = acc[ai][bj][m][0], v1 = acc[ai][bj][m][1];
                const u32x2 pw = pws[m]; const u32x4 hw = hws[m]; f32x4 h0 = {bflo(hw.x), bfhi(hw.x), bflo(hw.y), bfhi(hw.y)}, h1 = {bflo(hw.z), bfhi(hw.z), bflo(hw.w), bfhi(hw.w)};
                const f32x2 p0 = __builtin_amdgcn_cvt_pk_f32_fp8((int)pw.x, false), p1 = __builtin_amdgcn_cvt_pk_f32_fp8((int)pw.x, true), p2 = __builtin_amdgcn_cvt_pk_f32_fp8((int)pw.y, false), p3 = __builtin_amdgcn_cvt_pk_f32_fp8((int)pw.y, true);
                h0[0] += sigm(v0[0]) * p0.x; h0[1] += sigm(v0[1]) * p0.y; h0[2] += sigm(v0[2]) * p1.x; h0[3] += sigm(v0[3]) * p1.y;
                h1[0] += sigm(v1[0]) * p2.x; h1[1] += sigm(v1[1]) * p2.y; h1[2] += sigm(v1[2]) * p3.x; h1[3] += sigm(v1[3]) * p3.y;
                u32x4 w; w.x = cvt_pk_bf16_hz(h0[0], h0[1]); w.y = cvt_pk_bf16_hz(h0[2], h0[3]); w.z = cvt_pk_bf16_hz(h1[0], h1[1]); w.w = cvt_pk_bf16_hz(h1[2], h1[3]);
                *(u32x4*)(O + o) = w;
            EPI_ROWS_END
          }
    }
};
}

struct Frame {
    LAS unsigned char* lds; unsigned char* ws; const float* const* in; float* out;
    int tid, lane, wave, vcu, G, gw, NGW;
};
struct Args { const float* in[38]; float* out; unsigned char* ws; int ph_lo, ph_hi; };

__device__ __forceinline__ void tr_item(const float* W, int ldw, int k0, int n0, bf16* WT, size_t rowbase, int ldt, int kc0, LAS float* scr, int lane) {
    float v[32];
#pragma unroll
    for (int i = 0; i < 32; ++i) v[i] = W[(size_t)(k0 + 2 * i + (lane >> 5)) * ldw + n0 + (lane & 31)];
#pragma unroll
    for (int i = 0; i < 32; ++i) scr[(2 * i + (lane >> 5)) * 33 + (lane & 31)] = v[i];
    LDS_WAIT(); asm volatile("" ::: "memory");
    const int c = lane & 7;
#pragma unroll
    for (int j = 0; j < 4; ++j) { const int n = (lane >> 3) + 8 * j; const LAS float* s = scr + (8 * c) * 33 + n;
        u32x4 o; o.x = cvt_pk_bf16(s[0 * 33], s[1 * 33]); o.y = cvt_pk_bf16(s[2 * 33], s[3 * 33]); o.z = cvt_pk_bf16(s[4 * 33], s[5 * 33]); o.w = cvt_pk_bf16(s[6 * 33], s[7 * 33]);
        *(u32x4*)(WT + (rowbase + n) * ldt + kc0 + 8 * c) = o; }
    LDS_WAIT(); asm volatile("" ::: "memory");
}
__device__ __forceinline__ void tr_mat(const float* W, int K, int N, bf16* WT, size_t rowoff, int ldt, int kc0, int it, LAS float* scr, int lane) {
    const int nblk = N / 32, kb = it / nblk, nb = it % nblk;
    tr_item(W, N, 64 * kb, 32 * nb, WT, rowoff + 32 * nb, ldt, kc0 + 64 * kb, scr, lane);
}

__device__ __forceinline__ void tr_item8(const float* W, int ldw, int k0, int n0, unsigned char* WT, size_t rowbase, int ldt, int kc0, float scale, LAS float* scr, int lane) {
    float v[32];
#pragma unroll
    for (int i = 0; i < 32; ++i) v[i] = W[(size_t)(k0 + 2 * i + (lane >> 5)) * ldw + n0 + (lane & 31)];
#pragma unroll
    for (int i = 0; i < 32; ++i) scr[(2 * i + (lane >> 5)) * 33 + (lane & 31)] = v[i] * scale;
    LDS_WAIT(); asm volatile("" ::: "memory");
    const int c = lane & 3;
#pragma unroll
    for (int j = 0; j < 2; ++j) { const int n = (lane >> 2) + 16 * j; const LAS float* s = scr + (16 * c) * 33 + n;
        u32x4 o; o.x = pk4_fp8(s[0 * 33], s[1 * 33], s[2 * 33], s[3 * 33]); o.y = pk4_fp8(s[4 * 33], s[5 * 33], s[6 * 33], s[7 * 33]);
        o.z = pk4_fp8(s[8 * 33], s[9 * 33], s[10 * 33], s[11 * 33]); o.w = pk4_fp8(s[12 * 33], s[13 * 33], s[14 * 33], s[15 * 33]);
        *(u32x4*)(WT + (rowbase + n) * ldt + kc0 + 16 * c) = o; }
    LDS_WAIT(); asm volatile("" ::: "memory");
}
struct ConvItem { const float* src; unsigned char* dst; int ldw, ldt; float scale; };
__device__ __forceinline__ ConvItem conv_item(const float* const* in, unsigned char* ws, int it, int lane) {
    ConvItem c; const int e = it / 1536, r2 = it % 1536, which = r2 >> 9, q = r2 & 511;
    if (which < 2) { const float* src = e < 64 ? in[28 + which] + (size_t)e * 2048 * 512 : in[31 + which];
        const int kb = q >> 4, nb = q & 15, n0 = 32 * nb;
        c.src = src + (size_t)(64 * kb) * 512 + n0; c.ldw = 512; c.dst = ws + WS_WUP + ((size_t)e * 1024 + (n0 >> 7) * 256 + which * 128 + (n0 & 127)) * 2048 + 64 * kb; c.ldt = 2048; c.scale = 64.0f; }
    else { const float* src = e < 64 ? in[30] + (size_t)e * 512 * 2048 : in[33];
        const int kb = q >> 6, nb = q & 63;
        c.src = src + (size_t)(64 * kb) * 2048 + 32 * nb; c.ldw = 2048; c.dst = ws + WS_WDN + ((size_t)e * 2048 + 32 * nb) * 512 + 64 * kb; c.ldt = 512; c.scale = 32.0f; }
    return c;
}
__device__ __forceinline__ void conv_load(const ConvItem& c, float (&v)[32], int lane) {
#pragma unroll
    for (int i = 0; i < 32; ++i) v[i] = c.src[(size_t)(2 * i + (lane >> 5)) * c.ldw + (lane & 31)];
}
__device__ __forceinline__ void conv_store(const ConvItem& c, const float (&v)[32], LAS float* scr, int lane) {
#pragma unroll
    for (int i = 0; i < 32; ++i) scr[(2 * i + (lane >> 5)) * 33 + (lane & 31)] = v[i] * c.scale;
    LDS_WAIT(); asm volatile("" ::: "memory");
    const int cc = lane & 3;
#pragma unroll
    for (int j = 0; j < 2; ++j) { const int n = (lane >> 2) + 16 * j; const LAS float* s = scr + (16 * cc) * 33 + n;
        u32x4 o; o.x = pk4_fp8(s[0 * 33], s[1 * 33], s[2 * 33], s[3 * 33]); o.y = pk4_fp8(s[4 * 33], s[5 * 33], s[6 * 33], s[7 * 33]);
        o.z = pk4_fp8(s[8 * 33], s[9 * 33], s[10 * 33], s[11 * 33]); o.w = pk4_fp8(s[12 * 33], s[13 * 33], s[14 * 33], s[15 * 33]);
        *(u32x4*)(c.dst + (size_t)n * c.ldt + 16 * cc) = o; }
    LDS_WAIT(); asm volatile("" ::: "memory");
}
__device__ __forceinline__ void expert_conv_pair(const float* const* in, unsigned char* ws, int it0, int it1, LAS float* scr, int lane) {
    constexpr int NIT = 65 * 1536;
    if (it0 >= NIT) return;
    const ConvItem c0 = conv_item(in, ws, it0, lane); float v0[32]; conv_load(c0, v0, lane);
    if (it1 < NIT) { const ConvItem c1 = conv_item(in, ws, it1, lane); float v1[32]; conv_load(c1, v1, lane); conv_store(c0, v0, scr, lane); conv_store(c1, v1, scr, lane); }
    else conv_store(c0, v0, scr, lane);
}
struct ConvQ { const float* src; unsigned char* dst; int ldw, ldt; float scale; };
__device__ __forceinline__ ConvQ conv_quad_item(const float* const* in, unsigned char* ws, int it, int lane) {
    ConvQ c; const int e = it / 768, r2 = it % 768, which = r2 >> 8, q = r2 & 255, r = lane >> 5, cc = lane & 31;
    if (which < 2) { const float* W = e < 64 ? in[28 + which] + (size_t)e * 2048 * 512 : in[31 + which];
        const int kb = q >> 2, nb = q & 3; c.ldw = 512; c.ldt = 2048; c.scale = 64.0f;
        c.src = W + (size_t)(32 * kb + 16 * r) * 512 + 128 * nb + 4 * cc;
        c.dst = ws + WS_WUP + ((size_t)e * 1024 + nb * 256 + which * 128 + 4 * cc) * 2048 + 32 * kb + 16 * r; }
    else { const float* W = e < 64 ? in[30] + (size_t)e * 512 * 2048 : in[33];
        const int kb = q >> 4, nb = q & 15; c.ldw = 2048; c.ldt = 512; c.scale = 32.0f;
        c.src = W + (size_t)(32 * kb + 16 * r) * 2048 + 128 * nb + 4 * cc;
        c.dst = ws + WS_WDN + ((size_t)e * 2048 + 128 * nb + 4 * cc) * 512 + 32 * kb + 16 * r; }
    return c;
}
__device__ __forceinline__ void conv_quad_load(const ConvQ& c, f32x4 (&v)[16]) {
#pragma unroll
    for (int i = 0; i < 16; ++i) v[i] = *(const f32x4*)(c.src + (size_t)i * c.ldw);
}
__device__ __forceinline__ void conv_quad_store(const ConvQ& c, const f32x4 (&v)[16]) {
#pragma unroll
    for (int e4 = 0; e4 < 4; ++e4) { unsigned w[4];
#pragma unroll
        for (int g = 0; g < 4; ++g) w[g] = pk4_fp8(v[4 * g][e4] * c.scale, v[4 * g + 1][e4] * c.scale, v[4 * g + 2][e4] * c.scale, v[4 * g + 3][e4] * c.scale);
        *(u32x4*)(c.dst + (size_t)e4 * c.ldt) = (u32x4){w[0], w[1], w[2], w[3]}; }
}
__device__ __forceinline__ void rms_row_bf16(const float* xrow, const f32x4 (&gg8)[8], bf16* orow, unsigned char* orow8, int lane) {
    const f32x4* xr = (const f32x4*)xrow + lane;
    f32x4 v[8]; float s = 0.f;
#pragma unroll
    for (int j = 0; j < 8; ++j) { v[j] = xr[64 * j]; s += (v[j].x * v[j].x + v[j].y * v[j].y) + (v[j].z * v[j].z + v[j].w * v[j].w); }
    const float rstd = __builtin_amdgcn_rsqf(wave_sum(s) * (1.f / DM) + RMS_EPS);
    u32x2* o8 = (u32x2*)orow + lane; unsigned* o4 = (unsigned*)orow8 + lane;
#pragma unroll
    for (int j = 0; j < 8; ++j) { const f32x4 gg = gg8[j]; const float a = v[j].x * rstd * gg.x, b = v[j].y * rstd * gg.y, c = v[j].z * rstd * gg.z, d = v[j].w * rstd * gg.w;
        u32x2 w; w.x = cvt_pk_bf16(a, b); w.y = cvt_pk_bf16(c, d); o8[64 * j] = w; o4[64 * j] = pk4_fp8(a, b, c, d); }
}

__device__ __forceinline__ void p0_prologue(Frame& F) {
    LAS float* scr = (LAS float*)(F.lds + F.wave * 16384);
    unsigned char* ws = F.ws;
    bf16* W1 = (bf16*)(ws + WS_W1); bf16* WBR = (bf16*)(ws + WS_WBR); bf16* WOUT = (bf16*)(ws + WS_WOUT); bf16* WPG = (bf16*)(ws + WS_WPG); bf16* WPP = (bf16*)(ws + WS_WPP); bf16* WL = (bf16*)(ws + WS_WL);
    constexpr int I_IN = 32 * 205, I_BG = 32 * 128, I_BR = 16 * 64, I_O = 32 * 64, I_PP = 4 * 64, I_LO = 32;
    constexpr int NIT = I_IN + I_BG + 2 * I_BR + 2 * I_O + I_PP + 4 * I_LO;
    for (int it = F.gw; it < NIT; it += F.NGW) {
        int r = it;
        if (r < I_IN) { tr_mat(F.in[3], 2048, 6560, W1, 0, 2048, 0, r, scr, F.lane); continue; } r -= I_IN;
        if (r < I_BG) { const int kb = r >> 7, nb = r & 127; tr_item8(F.in[4], 4096, 64 * kb, 32 * nb, ws + WS_W1G8, (size_t)32 * nb, 2048, 64 * kb, 64.0f, scr, F.lane); continue; } r -= I_BG;
        if (r < I_BR) { tr_mat(F.in[22], 1024, 2048, WBR, 0, 1024, 0, r, scr, F.lane); continue; } r -= I_BR;
        if (r < I_BR) { tr_mat(F.in[23], 1024, 2048, WBR, 2048, 1024, 0, r, scr, F.lane); continue; } r -= I_BR;
        if (r < I_O) { tr_mat(F.in[24], 2048, 2048, WOUT, 0, 2048, 0, r, scr, F.lane); continue; } r -= I_O;
        if (r < I_O) { const int kb = r >> 6, nb = r & 63; tr_item8(F.in[35], 2048, 64 * kb, 32 * nb, (unsigned char*)WPG, (size_t)32 * nb, 2048, 64 * kb, 64.0f, scr, F.lane); continue; } r -= I_O;
        if (r < I_PP) { tr_mat(F.in[36], 256, 2048, WPP, 0, 2048, 0, r, scr, F.lane); continue; } r -= I_PP;
        { const int which = r / I_LO, nb = r % I_LO, d = which & 1;
          const float* src = (which < 2 ? F.in[13] : F.in[15]) + (size_t)d * 64 * 1024;
          tr_item(src, 1024, 0, 32 * nb, WL, (size_t)(which < 2 ? 0 : 2048) + d * 1024 + 32 * nb, 256, (which < 2 ? 0 : 128) + d * 64, scr, F.lane); }
    }
    const int gt = F.gw * 64 + F.lane, NGT = F.NGW * 64;
    for (int i = gt; i < 160 * 1024; i += NGT) { const int k = i >> 10, n = i & 1023; WL[(size_t)(4096 + n) * 256 + k] = (bf16)(cvt_pk_bf16(F.in[16][i], 0.f) & 0xffffu); }
    for (int i = gt; i < 5120 * 32; i += NGT) { const int row = i >> 5, k8 = (i & 31) * 8;
        const int k0 = row < 2048 ? (row >> 10) * 64 : row < 4096 ? 128 + ((row - 2048) >> 10) * 64 : 0, kl = row < 4096 ? 64 : 160;
        if (k8 < k0 || k8 >= k0 + kl) *(u32x4*)(WL + (size_t)row * 256 + k8) = (u32x4){0u, 0u, 0u, 0u}; }
    for (int i = gt; i < 96 * 256; i += NGT) *(u32x4*)(W1 + (size_t)6560 * 2048 + (size_t)i * 8) = (u32x4){0u, 0u, 0u, 0u};
    { bf16* WF = (bf16*)(ws + WS_WRT); const float* g = F.in[25]; const float* wr = F.in[26];
      for (int i = gt; i < 2048 * 64; i += NGT) { const int k = i >> 6, e = i & 63; const float v = g[k] * wr[i]; const unsigned hb = cvt_pk_bf16(v, 0.f) & 0xffffu; const float vh = __builtin_bit_cast(float, hb << 16);
          const size_t o = ((size_t)((k >> 4) * 4 + (e >> 5) * 2) * 64 + ((k >> 3) & 1) * 32 + (e & 31)) * 8 + (k & 7);
          WF[o] = (bf16)hb; WF[o + 512] = (bf16)(cvt_pk_bf16(v - vh, 0.f) & 0xffffu); } }
    { u32x2* PB = (u32x2*)(ws + WS_PB); const f32x4* p = (const f32x4*)F.in[1];
      for (int i = gt; i < NTOK * 256 / 4; i += NGT) { const f32x4 v = p[i]; u32x2 w; w.x = cvt_pk_bf16(v.x, v.y); w.y = cvt_pk_bf16(v.z, v.w); PB[i] = w; } }
    bf16* U = (bf16*)(ws + WS_U);
    f32x4 gg8[8];
#pragma unroll
    for (int j = 0; j < 8; ++j) gg8[j] = ((const f32x4*)F.in[2] + F.lane)[64 * j];
    for (int m = F.gw; m < NTOK; m += F.NGW) rms_row_bf16(F.in[0] + (size_t)m * DM, gg8, U + (size_t)m * DM, ws + WS_U8E + (size_t)m * DM, F.lane);
}

__device__ __forceinline__ void shift16(const bf16* zr, bool hasp, bool hasn, int c0, const float* mp, const float* mn, float (&o)[16]) {
#pragma unroll
    for (int hh = 0; hh < 2; ++hh) {
        float z[8], zp[8], zn[8];
        unpack8(*(const u32x4*)(zr + c0 + 8 * hh), z);
        if (hasp) unpack8(*(const u32x4*)(zr - ZLD + c0 + 8 * hh), zp);
        if (hasn) unpack8(*(const u32x4*)(zr + ZLD + c0 + 8 * hh), zn);
#pragma unroll
        for (int j = 0; j < 8; ++j) { const float p = hasp ? zp[j] : 0.f, n = hasn ? zn[j] : 0.f; o[8 * hh + j] = z[j] + mp[c0 + 8 * hh + j] * (p - z[j]) + mn[c0 + 8 * hh + j] * (n - z[j]); }
    }
}
struct ShRaw { u32x4 z[2], zp[2], zn[2]; };
__device__ __forceinline__ void shift_load(const bf16* zr, bool hasp, bool hasn, int c0, ShRaw& w) {
#pragma unroll
    for (int hh = 0; hh < 2; ++hh) { w.z[hh] = *(const u32x4*)(zr + c0 + 8 * hh);
        w.zp[hh] = hasp ? *(const u32x4*)(zr - ZLD + c0 + 8 * hh) : (u32x4){0u, 0u, 0u, 0u}; w.zn[hh] = hasn ? *(const u32x4*)(zr + ZLD + c0 + 8 * hh) : (u32x4){0u, 0u, 0u, 0u}; }
}
__device__ __forceinline__ void shift_comp(const ShRaw& w, int c0, const LAS float* mp, const LAS float* mn, float (&o)[16]) {
#pragma unroll
    for (int hh = 0; hh < 2; ++hh) { float z[8], zp[8], zn[8]; unpack8(w.z[hh], z); unpack8(w.zp[hh], zp); unpack8(w.zn[hh], zn);
        const f32x4 p0 = *(const LAS f32x4*)(mp + c0 + 8 * hh), p1 = *(const LAS f32x4*)(mp + c0 + 8 * hh + 4), n0 = *(const LAS f32x4*)(mn + c0 + 8 * hh), n1 = *(const LAS f32x4*)(mn + c0 + 8 * hh + 4);
#pragma unroll
        for (int j = 0; j < 4; ++j) { o[8 * hh + j] = z[j] + p0[j] * (zp[j] - z[j]) + n0[j] * (zn[j] - z[j]); o[8 * hh + 4 + j] = z[4 + j] + p1[j] * (zp[4 + j] - z[4 + j]) + n1[j] * (zn[4 + j] - z[4 + j]); } }
}
__device__ __forceinline__ void store16(bf16* dst, const float (&o)[16]) {
    float a[8], b[8];
#pragma unroll
    for (int j = 0; j < 8; ++j) { a[j] = o[j]; b[j] = o[8 + j]; }
    *(u32x4*)dst = pack8(a); *(u32x4*)(dst + 8) = pack8(b);
}
__device__ __forceinline__ void p2_shift(Frame& F) {
    unsigned char* ws = F.ws;
    const bf16* Z = (const bf16*)(ws + WS_Z); bf16* R = (bf16*)(ws + WS_R); bf16* KS = (bf16*)(ws + WS_KS); bf16* V = (bf16*)(ws + WS_V); bf16* KK = (bf16*)(ws + WS_KK); bf16* AP = (bf16*)(ws + WS_AP);
    const int lane = F.lane;
    LAS float* mp = (LAS float*)F.lds; LAS float* mn = mp + 3584; LAS float* k_k = mn + 3584;
    for (int i = F.tid; i < 3488; i += 512) { mp[i] = F.in[10][i]; mn[i] = F.in[11][i]; }
    for (int i = F.tid; i < 1024; i += 512) k_k[i] = F.in[17][i];
    __syncthreads();
    for (int t = F.gw; t < NTOK; t += F.NGW) {
        const int tt = t & (SEQ - 1); const bool hasp = tt != 0, hasn = tt != SEQ - 1;
        const bf16* zr = Z + (size_t)t * ZLD + ZR;
        ShRaw wR, wV, wK, wL; float o[16], oL[16];
        shift_load(zr, hasp, hasn, 16 * lane, wR); shift_load(zr, hasp, hasn, 2048 + 16 * lane, wV); shift_load(zr, hasp, hasn, 1024 + 16 * lane, wK);
        if (lane < 26) shift_load(zr, hasp, hasn, 3072 + 16 * lane, wL);
        shift_comp(wR, 16 * lane, mp, mn, o); store16(R + (size_t)t * 1024 + 16 * lane, o);
        shift_comp(wV, 2048 + 16 * lane, mp, mn, o); store16(V + (size_t)t * 1024 + 16 * lane, o);
        if (lane < 26) shift_comp(wL, 3072 + 16 * lane, mp, mn, oL);
        shift_comp(wK, 1024 + 16 * lane, mp, mn, o); store16(KS + (size_t)t * 1024 + 16 * lane, o);
        float ss = 0.f;
#pragma unroll
        for (int j = 0; j < 16; ++j) { o[j] *= k_k[16 * lane + j]; ss += o[j] * o[j]; }
        ss = quad_sum(ss);
        const float rn = __builtin_amdgcn_rsqf(fmaxf(ss, 1e-12f));
#pragma unroll
        for (int j = 0; j < 16; ++j) o[j] *= rn;
        store16(KK + (size_t)t * 1024 + 16 * lane, o);
        if (lane < 32) {
            if (lane < 26) {
                if (lane < 8) {
#pragma unroll
                    for (int j = 0; j < 16; ++j) { const float e = ex2(2.0f * LOG2E * oL[j]); oL[j] = 1.0f - 2.0f * __builtin_amdgcn_rcpf(e + 1.0f); }
                } else if (lane >= 16) {
#pragma unroll
                    for (int j = 0; j < 16; ++j) oL[j] = sigm(oL[j]);
                } }
            else {
#pragma unroll
                for (int j = 0; j < 16; ++j) oL[j] = 0.f; }
            store16(AP + (size_t)t * 512 + 16 * lane, oL);
        }
    }
    __syncthreads();
    bf16* VT = (bf16*)(ws + WS_VT);
    LAS bf16* scr = (LAS bf16*)(F.lds + F.wave * 16640);
    for (int it = F.gw; it < NB * 8 * 32; it += F.NGW) {
        const int tb = it & 31, bh = it >> 5, b = bh >> 3, h = bh & 7;
        const bf16* src = Z + (size_t)(b * SEQ + tb * 64) * ZLD + 2048 + h * 128 + 2 * lane;
#pragma unroll 8
        for (int r = 0; r < 64; ++r) *(LAS unsigned*)(scr + r * 130 + 2 * lane) = *(const unsigned*)(src + (size_t)r * ZLD);
        LDS_WAIT(); asm volatile("" ::: "memory");
        const int dvr = lane >> 3, c = lane & 7;
#pragma unroll 4
        for (int i = 0; i < 16; ++i) { const int dv = 8 * i + dvr; const LAS bf16* s = scr + (8 * c) * 130 + dv;
            u32x4 w; w.x = (unsigned)s[0] | ((unsigned)s[130] << 16); w.y = (unsigned)s[260] | ((unsigned)s[390] << 16); w.z = (unsigned)s[520] | ((unsigned)s[650] << 16); w.w = (unsigned)s[780] | ((unsigned)s[910] << 16);
            *(u32x4*)(VT + ((size_t)bh * 128 + dv) * SEQ + tb * 64 + 8 * c) = w; }
        LDS_WAIT(); asm volatile("" ::: "memory");
    }
}

constexpr int ATT_KP = 272, ATT_VP = 144, ATT_KB = 64 * ATT_KP, ATT_VB = 128 * ATT_VP, ATT_BUF = ATT_KB + ATT_VB;
__device__ __forceinline__ void attn_phase(Frame& F) {
    unsigned char* ws = F.ws;
    const bf16* Z = (const bf16*)(ws + WS_Z); const bf16* VT = (const bf16*)(ws + WS_VT); bf16* YA = (bf16*)(ws + WS_YA);
    const int tid = F.tid, lane = F.lane, wave = F.wave, qs = wave & 3, map = wave >> 2, c = lane & 31, hh = lane >> 5;
    float lam;
    { const float a = wave_sum(F.in[5][lane] * F.in[6][lane]), b2 = wave_sum(F.in[7][lane] * F.in[8][lane]); lam = ex2(a * LOG2E) - ex2(b2 * LOG2E) + 0.2f; }
    const float* subg = F.in[9];
    LAS unsigned char* lds = F.lds;
    if (wave >= 4) __builtin_amdgcn_s_setprio(1);
    for (int ui = 0; ui < 4; ++ui) {
        if (F.vcu >= 256) break;
        const int b = F.vcu >> 5, qb = (F.vcu >> 1) & 15, ty = F.vcu & 1;
        const int h = (ui == 0) ? ty : (ui == 1) ? 7 - ty : (ui == 2) ? 3 - ty : 4 + ty;
        const int bh = b * 8 + h;
        const int tok0 = b * SEQ, q0 = qb * 128 + qs * 32;
        const float slope2 = ex2(-(float)(h + 1)) * LOG2E;
        const float sc2 = 0.125f * LOG2E;
        bf16x8 qf[4];
        { const bf16* qp = Z + (size_t)(tok0 + q0 + c) * ZLD + h * 128 + map * 64 + 8 * hh;
#pragma unroll
          for (int s = 0; s < 4; ++s) qf[s] = *(const bf16x8*)(qp + 16 * s); }
        f32x16 O[4];
#pragma unroll
        for (int d = 0; d < 4; ++d)
#pragma unroll
            for (int j = 0; j < 16; ++j) O[d][j] = 0.f;
        float mrun = -1e30f, muse = -1e30f, lrun = 0.f;
        const float cc = ex2((float)(2 - h)); const int q0w = q0;
        unsigned qaug1 = 0u, kaug1[2] = {0u, 0u};
        if (hh == 0) { qaug1 = cvt_pk_bf16((float)c, 1.0f);
#pragma unroll
          for (int kb = 0; kb < 2; ++kb) kaug1[kb] = cvt_pk_bf16(-cc, cc * (float)(32 * kb + c)); }
        const int dtile = q0w >> 6;
        unsigned koff[2], voff[2]; int kdst[2], vdst[2];
        const char* Zb = (const char*)(Z + (size_t)tok0 * ZLD + 1024 + h * 128); const char* Vb = (const char*)(VT + (size_t)bh * 128 * SEQ);
#pragma unroll
        for (int i = 0; i < 2; ++i) { const int q = tid + 512 * i;
            koff[i] = (unsigned)((q >> 4) * ZLD + (q & 15) * 8) * 2u; kdst[i] = (q >> 4) * ATT_KP + (q & 15) * 16;
            voff[i] = (unsigned)((q >> 3) * SEQ + (q & 7) * 8) * 2u; vdst[i] = ATT_KB + (q >> 3) * ATT_VP + ((q & 7) >> 1) * 32 + (q & 1) * 8; }
        u32x4 kr[2], vr[2];
        int tlo, thi;
        { const unsigned* T = (const unsigned*)(ws + WS_CTL) + CW_QKN + b * 64 + h * 4;
          float bmax = 0.f;
#pragma unroll
          for (int mp = 0; mp < 2; ++mp) {
              const float q2 = __uint_as_float(__hip_atomic_load(T + mp * 2, __ATOMIC_RELAXED, __HIP_MEMORY_SCOPE_AGENT)) + __uint_as_float(__hip_atomic_load(T + mp * 2 + 1, __ATOMIC_RELAXED, __HIP_MEMORY_SCOPE_AGENT));
              const float k2 = __uint_as_float(__hip_atomic_load(T + 32 + mp * 2, __ATOMIC_RELAXED, __HIP_MEMORY_SCOPE_AGENT)) + __uint_as_float(__hip_atomic_load(T + 32 + mp * 2 + 1, __ATOMIC_RELAXED, __HIP_MEMORY_SCOPE_AGENT));
              bmax = fmaxf(bmax, q2 * k2); }
          const float Bb = __builtin_sqrtf(bmax) * sc2 * 1.02f;
          const float dk = fminf((30.0f + 2.0f * Bb) / slope2, 4096.0f);
          const int Di = __builtin_amdgcn_readfirstlane((int)dk + 1), q0b = qb * 128;
          const int a = q0b - 63 - Di; tlo = a <= 0 ? 0 : (a + 63) >> 6;
          const int e = (q0b + 127 + Di) >> 6; thi = e > 31 ? 31 : e; }
        const int nt = thi - tlo + 1;
        const int t0 = 2 * qb;
#pragma unroll
        for (int i = 0; i < 2; ++i) { kr[i] = *(const u32x4*)(Zb + (size_t)(t0 * 64) * ZLD * 2 + koff[i]); vr[i] = *(const u32x4*)(Vb + t0 * 64 * 2 + voff[i]); }
#pragma unroll
        for (int i = 0; i < 2; ++i) { *(LAS u32x4*)(lds + kdst[i]) = kr[i]; *(LAS u32x2*)(lds + vdst[i]) = (u32x2){vr[i].x, vr[i].y}; *(LAS u32x2*)(lds + vdst[i] + 16) = (u32x2){vr[i].z, vr[i].w}; }
        __syncthreads();
        for (int it = 0; it < nt; ++it) {
            int xt = t0 - tlo + it; if (xt >= nt) xt -= nt;
            const int tt = tlo + xt, j0 = tt * 64; LAS unsigned char* buf = lds + (it & 1) * ATT_BUF;
            if (it + 1 < nt) { int xn = xt + 1; if (xn >= nt) xn -= nt; const int jn = (tlo + xn) * 64;
#pragma unroll
                for (int i = 0; i < 2; ++i) { kr[i] = *(const u32x4*)(Zb + (size_t)jn * ZLD * 2 + koff[i]); vr[i] = *(const u32x4*)(Vb + jn * 2 + voff[i]); } }
            const bool diag = (tt == dtile), left = (j0 < q0w);
            f32x16 S[2];
            { bf16x8 kf[2][4];
#pragma unroll
              for (int kb = 0; kb < 2; ++kb)
#pragma unroll
                for (int s = 0; s < 4; ++s) kf[kb][s] = *(const LAS bf16x8*)(buf + (32 * kb + c) * ATT_KP + (map * 64 + 16 * s + 8 * hh) * 2);
              __builtin_amdgcn_sched_barrier(0);
#pragma unroll
              for (int kb = 0; kb < 2; ++kb) {
#pragma unroll
                for (int j = 0; j < 16; ++j) S[kb][j] = 0.f;
#pragma unroll
                for (int s = 0; s < 4; ++s) S[kb] = __builtin_amdgcn_mfma_f32_32x32x16_bf16(kf[kb][s], qf[s], S[kb], 0, 0, 0); } }
            float tb2;
            if (!diag) {
#pragma unroll
                for (int kb = 0; kb < 2; ++kb) { u32x4 k = {kaug1[kb], 0u, 0u, 0u}; if (!left) k.x ^= 0x80008000u; const u32x4 qa = {qaug1, 0u, 0u, 0u};
                    S[kb] = __builtin_amdgcn_mfma_f32_32x32x16_bf16(__builtin_bit_cast(bf16x8, k), __builtin_bit_cast(bf16x8, qa), S[kb], 0, 0, 0); }
                tb2 = -slope2 * (float)(left ? (q0w - j0) : (j0 - q0w));
            } else {
                int dd0 = q0w + c - j0 - 4 * hh; asm volatile("" : "+v"(dd0));
#pragma unroll
                for (int kb = 0; kb < 2; ++kb)
#pragma unroll
                    for (int r = 0; r < 16; ++r) { const int dd = dd0 - (32 * kb + (r & 3) + 8 * (r >> 2)); S[kb][r] -= cc * (float)(dd < 0 ? -dd : dd); }
                tb2 = 0.f;
            }
            float mx = -1e30f;
#pragma unroll
            for (int kb = 0; kb < 2; ++kb)
#pragma unroll
                for (int r = 0; r < 16; ++r) mx = fmaxf(mx, S[kb][r]);
            mx = mx * sc2 + tb2;
            mx = fmaxf(mx, __shfl_xor(mx, 32));
            const float mnew = fmaxf(mrun, mx);
            const bool skip = __all(mx < mrun - 30.0f);
            mrun = mnew;
            if (!skip) {
                if (__any(mnew > muse + 8.0f)) {
                    const float alpha = ex2(muse - mnew); muse = mnew; lrun *= alpha;
#pragma unroll
                    for (int d = 0; d < 4; ++d)
#pragma unroll
                        for (int j = 0; j < 16; ++j) O[d][j] *= alpha; }
                const float off = tb2 - muse;
                float ls = 0.f; bf16x8 pf[2][2];
#pragma unroll
                for (int kb = 0; kb < 2; ++kb)
#pragma unroll
                    for (int s = 0; s < 2; ++s) { float p[8];
#pragma unroll
                        for (int j = 0; j < 8; ++j) { p[j] = ex2(__builtin_fmaf(S[kb][8 * s + j], sc2, off)); ls += p[j]; }
                        const u32x4 w = pack8(p); pf[kb][s] = __builtin_bit_cast(bf16x8, w); }
                lrun += ls;
                __builtin_amdgcn_sched_barrier(0);
                u32x4 vw[8];
#define ATT_VLOAD(i_) { vw[(i_) & 7] = *(const LAS u32x4*)(buf + ATT_KB + (32 * ((i_) >> 2) + c) * ATT_VP + ((i_) & 3) * 32 + hh * 16); }
#pragma unroll
                for (int i = 0; i < 8; ++i) ATT_VLOAD(i)
                __builtin_amdgcn_sched_barrier(0);
#pragma unroll
                for (int i = 0; i < 16; ++i) {
                    O[i >> 2] = __builtin_amdgcn_mfma_f32_32x32x16_bf16(__builtin_bit_cast(bf16x8, vw[i & 7]), pf[(i >> 1) & 1][i & 1], O[i >> 2], 0, 0, 0);
                    if (i + 8 < 16) ATT_VLOAD(i + 8)
                    __builtin_amdgcn_sched_barrier(0);
                }
#undef ATT_VLOAD
            }
            if (it + 1 < nt) { LAS unsigned char* nb = lds + ((it + 1) & 1) * ATT_BUF;
#pragma unroll
                for (int i = 0; i < 2; ++i) { *(LAS u32x4*)(nb + kdst[i]) = kr[i]; *(LAS u32x2*)(nb + vdst[i]) = (u32x2){vr[i].x, vr[i].y}; *(LAS u32x2*)(nb + vdst[i] + 16) = (u32x2){vr[i].z, vr[i].w}; } }
            __syncthreads();
        }
        const float ltot = lrun + __shfl_xor(lrun, 32); const float inv = __builtin_amdgcn_rcpf(ltot);
        LAS float* X = (LAS float*)lds;
        int tl = tid; asm volatile("" : "+v"(tl));
        const int c = tl & 31, hh = (tl >> 5) & 1, qs = (tl >> 6) & 3;
        if (map == 1) {
#pragma unroll
            for (int d = 0; d < 4; ++d)
#pragma unroll
                for (int g = 0; g < 4; ++g) { f32x4 v;
#pragma unroll
                    for (int j = 0; j < 4; ++j) v[j] = O[d][4 * g + j] * (inv * lam);
                    *(LAS f32x4*)(X + (qs * 32 + c) * 132 + 32 * d + 8 * g + 4 * hh) = v; }
        }
        __syncthreads();
        if (map == 0) {
            float ss = 0.f;
#pragma unroll
            for (int d = 0; d < 4; ++d)
#pragma unroll
                for (int g = 0; g < 4; ++g) { const f32x4 x = *(const LAS f32x4*)(X + (qs * 32 + c) * 132 + 32 * d + 8 * g + 4 * hh);
#pragma unroll
                    for (int j = 0; j < 4; ++j) { const float o = O[d][4 * g + j] * inv - x[j]; O[d][4 * g + j] = o; ss += o * o; } }
            ss += __shfl_xor(ss, 32);
            const float rn = __builtin_amdgcn_rsqf(ss * (1.f / 128.f) + RMS_EPS) * 0.8f;
            bf16* yp = YA + (size_t)(tok0 + q0 + c) * 1024 + h * 128;
            f32x4 sgv[4][4];
#pragma unroll
            for (int d = 0; d < 4; ++d)
#pragma unroll
                for (int g = 0; g < 4; ++g) sgv[d][g] = *(const f32x4*)(subg + 32 * d + 8 * g + 4 * hh);
#pragma unroll
            for (int d = 0; d < 4; ++d)
#pragma unroll
                for (int g = 0; g < 4; ++g) { const int dv = 32 * d + 8 * g + 4 * hh; const f32x4 sg = sgv[d][g];
                    u32x2 w; w.x = cvt_pk_bf16(O[d][4 * g] * rn * sg[0], O[d][4 * g + 1] * rn * sg[1]); w.y = cvt_pk_bf16(O[d][4 * g + 2] * rn * sg[2], O[d][4 * g + 3] * rn * sg[3]);
                    *(u32x2*)(yp + dv) = w; }
        }
        __syncthreads();
    }
    __builtin_amdgcn_s_setprio(0);
}

constexpr int SCN_VEC = 0, SCN_WLO = 8192, SCN_WHI = SCN_WLO + 4352, SCN_KB = SCN_WHI + 4352, SCN_V = SCN_KB + 8704, SCN_SC = SCN_V + 8192, SCN_BUF = SCN_SC + 512;
constexpr int SCN_YST = 2 * SCN_BUF, SCN_END = SCN_YST + 2 * 8192;
static_assert(SCN_END <= LDSCTL_OFF, "scan LDS map");
struct ScanRegs { u32x2 r, kk, v, kt, bv, dd; };
template <bool CONV> __device__ __forceinline__ void scan_phase(Frame& F) {
    unsigned char* ws = F.ws;
    const int tid = F.tid, seq = F.vcu; if (seq >= 256) return;
    const int dir = seq >> 7, b = (seq >> 4) & 7, h = seq & 15;
    const bf16* R = (const bf16*)(ws + WS_R); const bf16* KK = (const bf16*)(ws + WS_KK); const bf16* V = (const bf16*)(ws + WS_V);
    const bf16* KT = (const bf16*)(ws + WS_KT) + (size_t)dir * NTOK * 1024; const bf16* BV = (const bf16*)(ws + WS_BV) + (size_t)dir * NTOK * 1024;
    const bf16* DD = (const bf16*)(ws + WS_WD) + (size_t)dir * NTOK * 1024; bf16* YS = (bf16*)(ws + WS_YS) + (size_t)dir * NTOK * 1024;
    LAS unsigned char* L = F.lds;
    for (int k = tid; k < 2 * 16 * 16; k += 512) { const int bi = k >> 8, r2 = k & 255, st = r2 >> 4, w = r2 & 15;
        const int off = (w < 4) ? SCN_WLO + st * 272 + 256 + 4 * w : (w < 8) ? SCN_WHI + st * 272 + 256 + 4 * (w - 4) : SCN_KB + st * 544 + 512 + 4 * (w - 8);
        *(LAS unsigned*)(L + bi * SCN_BUF + off) = 0u; }
    const int t4 = tid & 255, part = t4 & 15, lsA = t4 >> 4, lsB = lsA + 16;
    auto gload = [&](ScanRegs& g, int cchunk, int ls) { const int tt = cchunk * 32 + ls; const int t = dir ? (SEQ - 1 - tt) : tt; const size_t o = (size_t)(b * SEQ + t) * 1024 + h * 64 + 4 * part;
        g.r = *(const u32x2*)(R + o); g.kk = *(const u32x2*)(KK + o); g.v = *(const u32x2*)(V + o); g.kt = *(const u32x2*)(KT + o); g.bv = *(const u32x2*)(BV + o); g.dd = *(const u32x2*)(DD + o); };
    auto lstore = [&](const ScanRegs& g, int bi, int ls) { LAS unsigned char* B = L + bi * SCN_BUF; const int pr = ls >> 1; const bool odd = ls & 1;
        const f32x4 lw = 1.0f - (f32x4){bflo(g.dd.x), bfhi(g.dd.x), bflo(g.dd.y), bfhi(g.dd.y)};
        const f32x4 r = {bflo(g.r.x), bfhi(g.r.x), bflo(g.r.y), bfhi(g.r.y)}, kk = {bflo(g.kk.x), bfhi(g.kk.x), bflo(g.kk.y), bfhi(g.kk.y)}, v = {bflo(g.v.x), bfhi(g.v.x), bflo(g.v.y), bfhi(g.v.y)};
        const f32x4 kt = {bflo(g.kt.x), bfhi(g.kt.x), bflo(g.kt.y), bfhi(g.kt.y)}, bb = {bflo(g.bv.x), bfhi(g.bv.x), bflo(g.bv.y), bfhi(g.bv.y)};
        f32x4 wp; wp.x = __shfl_xor(lw.x, 16); wp.y = __shfl_xor(lw.y, 16); wp.z = __shfl_xor(lw.z, 16); wp.w = __shfl_xor(lw.w, 16);
        const unsigned pk0 = __shfl_xor(g.kk.x, 16), pk1 = __shfl_xor(g.kk.y, 16), pr0 = __shfl_xor(g.r.x, 16), pr1 = __shfl_xor(g.r.y, 16);
        const f32x4 kkp = {bflo(pk0), bfhi(pk0), bflo(pk1), bfhi(pk1)}, rp = {bflo(pr0), bfhi(pr0), bflo(pr1), bfhi(pr1)};
        float s0, s1, s2 = 0.f, s3 = 0.f, s4 = 0.f, s5 = 0.f;
        s0 = (bb.x * r.x + bb.y * r.y) + (bb.z * r.z + bb.w * r.w);
        s1 = (kt.x * r.x + kt.y * r.y) + (kt.z * r.z + kt.w * r.w);
        if (!odd) {
            const f32x4 wr = lw * r, w01 = lw * wp, ktw = kt * wp, bbw = bb * wp;
            *(LAS u32x2*)(B + SCN_VEC + pr * 512 + 8 * part) = g.kk;
            *(LAS u32x2*)(B + SCN_VEC + pr * 512 + 128 + 8 * part) = (u32x2){cvt_pk_bf16(wr.x, wr.y), cvt_pk_bf16(wr.z, wr.w)};
            const u32x4 wl = {cvt_pk_bf16(w01.x, 0.f), cvt_pk_bf16(w01.y, 0.f), cvt_pk_bf16(w01.z, 0.f), cvt_pk_bf16(w01.w, 0.f)};
            *(LAS u32x4*)(B + SCN_WLO + pr * 272 + 16 * part) = wl;
            *(LAS u32x4*)(B + SCN_WHI + pr * 272 + 16 * part) = (u32x4){wl.x << 16, wl.y << 16, wl.z << 16, wl.w << 16};
            LAS unsigned* kb = (LAS unsigned*)(B + SCN_KB + pr * 544 + 32 * part);
            kb[0] = cvt_pk_bf16(ktw.x, -bbw.x); kb[2] = cvt_pk_bf16(ktw.y, -bbw.y); kb[4] = cvt_pk_bf16(ktw.z, -bbw.z); kb[6] = cvt_pk_bf16(ktw.w, -bbw.w);
            *(LAS f32x4*)(B + SCN_V + pr * 512 + 16 * part) = v;
            s2 = (kt.x * kkp.x + kt.y * kkp.y) + (kt.z * kkp.z + kt.w * kkp.w);
            s3 = (bb.x * kkp.x + bb.y * kkp.y) + (bb.z * kkp.z + bb.w * kkp.w);
            s4 = (ktw.x * rp.x + ktw.y * rp.y) + (ktw.z * rp.z + ktw.w * rp.w);
            s5 = (bbw.x * rp.x + bbw.y * rp.y) + (bbw.z * rp.z + bbw.w * rp.w);
        } else {
            const f32x4 qk = wp * kk, qr = wp * lw * r;
            *(LAS u32x2*)(B + SCN_VEC + pr * 512 + 256 + 8 * part) = (u32x2){cvt_pk_bf16(qk.x, qk.y), cvt_pk_bf16(qk.z, qk.w)};
            *(LAS u32x2*)(B + SCN_VEC + pr * 512 + 384 + 8 * part) = (u32x2){cvt_pk_bf16(qr.x, qr.y), cvt_pk_bf16(qr.z, qr.w)};
            LAS unsigned* kb = (LAS unsigned*)(B + SCN_KB + pr * 544 + 32 * part);
            kb[1] = cvt_pk_bf16(kt.x, -bb.x); kb[3] = cvt_pk_bf16(kt.y, -bb.y); kb[5] = cvt_pk_bf16(kt.z, -bb.z); kb[7] = cvt_pk_bf16(kt.w, -bb.w);
            *(LAS f32x4*)(B + SCN_V + pr * 512 + 256 + 16 * part) = v;
        }
#pragma unroll
        for (int o = 0; o < 1; ++o) { s0 = row16_sum(s0); s1 = row16_sum(s1); s2 = row16_sum(s2); s3 = row16_sum(s3); s4 = row16_sum(s4); s5 = row16_sum(s5); }
        if (part == 0) { LAS float* sc = (LAS float*)(B + SCN_SC + pr * 32);
            if (!odd) { sc[0] = s0; sc[1] = s1; sc[2] = s2; sc[3] = s3; sc[4] = s4; sc[5] = s5; } else { sc[6] = s0; sc[7] = s1; } } };
    auto ystore = [&](int cchunk, int ls) { const LAS float* Y = (const LAS float*)(L + SCN_YST + (cchunk & 1) * 8192); const int tt = cchunk * 32 + ls; const int t = dir ? (SEQ - 1 - tt) : tt;
        const f32x4 yv = *(const LAS f32x4*)(Y + ls * 64 + 4 * part);
        *(u32x2*)(YS + (size_t)(b * SEQ + t) * 1024 + h * 64 + 4 * part) = (u32x2){cvt_pk_bf16(yv.x, yv.y), cvt_pk_bf16(yv.z, yv.w)}; };
    const int lane = F.lane, m = lane & 15, q = lane >> 4, wv = F.wave & 3;
    const bool act = (q == (m >> 2));
    const int o_vec = SCN_VEC + (m & 3) * 128 + 8 * q, o_v = SCN_V + 4 * (16 * wv + m);
    int o_w0[4], o_w1[4], o_kb[4];
#pragma unroll
    for (int t = 0; t < 4; ++t) { const int j = 16 * t + m, wsel = ((m & 1) ? SCN_WHI : SCN_WLO) + 4 * j, zero = SCN_WLO + 256;
        o_w0[t] = (act && (m & 3) < 2) ? wsel : zero; o_w1[t] = (act && (m & 3) >= 2) ? wsel : zero; o_kb[t] = SCN_KB + ((q == 0) ? 8 * j : 512); }
    f32x4 St[4];
#pragma unroll
    for (int t = 0; t < 4; ++t) St[t] = (f32x4){0.f, 0.f, 0.f, 0.f};
    ScanRegs gA{}, gB{};
    const bool loader = tid >= 256;
    if (loader) __builtin_amdgcn_s_setprio(1);
    if (loader) { gload(gA, 0, lsA); gload(gB, 0, lsB); lstore(gA, 0, lsA); lstore(gB, 0, lsB); gload(gA, 1, lsA); gload(gB, 1, lsB); }
    __syncthreads();
    for (int cch = 0; cch < 64; ++cch) {
        const int bi = cch & 1;
        if (!loader) {
            const LAS unsigned char* B = L + bi * SCN_BUF; LAS float* YST = (LAS float*)(L + SCN_YST + bi * 8192);
            const LAS unsigned char* p_vec = B + o_vec; const LAS unsigned char* p_v = B + o_v;
            const LAS unsigned char* p_w0[4]; const LAS unsigned char* p_w1[4]; const LAS unsigned char* p_kb[4];
#pragma unroll
            for (int t = 0; t < 4; ++t) { p_w0[t] = B + o_w0[t]; p_w1[t] = B + o_w1[t]; p_kb[t] = B + o_kb[t]; }
#pragma unroll
            for (int p = 0; p < 16; ++p) {
                const u32x2 a0 = *(const LAS u32x2*)(p_vec + p * 512), a1 = *(const LAS u32x2*)(p_vec + p * 512 + 32), a2 = *(const LAS u32x2*)(p_vec + p * 512 + 64), a3 = *(const LAS u32x2*)(p_vec + p * 512 + 96);
                unsigned w0[4], w1[4]; u32x2 kb[4];
#pragma unroll
                for (int t = 0; t < 4; ++t) { w0[t] = *(const LAS unsigned*)(p_w0[t] + p * 272); w1[t] = *(const LAS unsigned*)(p_w1[t] + p * 272); kb[t] = *(const LAS u32x2*)(p_kb[t] + p * 544); }
                const float v0 = *(const LAS float*)(p_v + p * 512), v1 = *(const LAS float*)(p_v + p * 512 + 256);
                const f32x4 c0 = *(const LAS f32x4*)(B + SCN_SC + p * 32), c1 = *(const LAS f32x4*)(B + SCN_SC + p * 32 + 16);
                unsigned bp[4][2];
#pragma unroll
                for (int t = 0; t < 4; ++t) { bp[t][0] = cvt_pk_bf16_hz(St[t][0], St[t][1]); bp[t][1] = cvt_pk_bf16_hz(St[t][2], St[t][3]); }
                f32x4 P = {0.f, 0.f, 0.f, 0.f};
                P = __builtin_amdgcn_mfma_f32_16x16x32_bf16(__builtin_bit_cast(bf16x8, ((u32x4){a0.x, a0.y, a1.x, a1.y})), __builtin_bit_cast(bf16x8, ((u32x4){bp[0][0], bp[0][1], bp[1][0], bp[1][1]})), P, 0, 0, 0);
                P = __builtin_amdgcn_mfma_f32_16x16x32_bf16(__builtin_bit_cast(bf16x8, ((u32x4){a2.x, a2.y, a3.x, a3.y})), __builtin_bit_cast(bf16x8, ((u32x4){bp[2][0], bp[2][1], bp[3][0], bp[3][1]})), P, 0, 0, 0);
                const float sa0 = P[0];
                const float sa1 = P[2] - sa0 * c0.w + v0 * c0.z;
                const float y0 = P[1] - sa0 * c0.x + v0 * c0.y;
                const float y1 = P[3] - sa0 * c1.y + v0 * c1.x - sa1 * c1.z + v1 * c1.w;
                YST[(2 * p) * 64 + 16 * wv + m] = y0; YST[(2 * p + 1) * 64 + 16 * wv + m] = y1;
                const unsigned vs0 = cvt_pk_bf16_hz(v0, sa0), vs1 = cvt_pk_bf16_hz(v1, sa1);
#pragma unroll
                for (int t = 0; t < 4; ++t)
                    St[t] = __builtin_amdgcn_mfma_f32_16x16x32_bf16(__builtin_bit_cast(bf16x8, ((u32x4){w0[t], w1[t], kb[t].x, kb[t].y})), __builtin_bit_cast(bf16x8, ((u32x4){bp[t][0], bp[t][1], vs0, vs1})), (f32x4){0.f, 0.f, 0.f, 0.f}, 0, 0, 0);
            }
        } else {
            ConvQ cq{}; f32x4 cv[16]; bool conv = false;
            if constexpr (CONV) { const int n0 = (cch * 49) >> 6, n1 = ((cch + 1) * 49) >> 6; const int it = F.vcu * 4 + (F.wave - 4) + 1024 * n0;
                conv = (n1 > n0) && it < 65 * 768;
                if (conv) { cq = conv_quad_item(F.in, F.ws, it, lane); conv_quad_load(cq, cv); } }
            if (cch + 1 < 64) { lstore(gA, bi ^ 1, lsA); lstore(gB, bi ^ 1, lsB); }
            if (cch + 2 < 64) { gload(gA, cch + 2, lsA); gload(gB, cch + 2, lsB); }
            if (cch >= 1) { ystore(cch - 1, lsA); ystore(cch - 1, lsB); }
            if constexpr (CONV) { if (conv) conv_quad_store(cq, cv); }
        }
        __syncthreads();
    }
    __builtin_amdgcn_s_setprio(0);
    if (loader) { ystore(63, lsA); ystore(63, lsB); }
}

__device__ __forceinline__ void p5_post(Frame& F) {
    unsigned char* ws = F.ws; const int lane = F.lane;
    const bf16* YS = (const bf16*)(ws + WS_YS); const bf16* R = (const bf16*)(ws + WS_R); const bf16* V = (const bf16*)(ws + WS_V); const bf16* KT = (const bf16*)(ws + WS_KT);
    const bf16* GG = (const bf16*)(ws + WS_G); bf16* YR = (bf16*)(ws + WS_YR);
    const float* r_k = F.in[19]; const float* lg = F.in[20]; const float* lb = F.in[21];
    for (int t = F.gw; t < NTOK; t += F.NGW) {
        const size_t o = (size_t)t * 1024 + 16 * lane;
        float y[16], r[16], k0[16], k1[16], v[16], g[16];
#pragma unroll
        for (int hh = 0; hh < 2; ++hh) { float ya[8], yb[8]; unpack8(*(const u32x4*)(YS + o + 8 * hh), ya); unpack8(*(const u32x4*)(YS + (size_t)NTOK * 1024 + o + 8 * hh), yb);
#pragma unroll
            for (int j = 0; j < 8; ++j) y[8 * hh + j] = ya[j] + yb[j]; }
#pragma unroll
        for (int hh = 0; hh < 2; ++hh) { float tmp[8];
            unpack8(*(const u32x4*)(R + o + 8 * hh), tmp);
#pragma unroll
            for (int j = 0; j < 8; ++j) r[8 * hh + j] = tmp[j];
            unpack8(*(const u32x4*)(KT + o + 8 * hh), tmp);
#pragma unroll
            for (int j = 0; j < 8; ++j) k0[8 * hh + j] = tmp[j];
            unpack8(*(const u32x4*)(KT + (size_t)NTOK * 1024 + o + 8 * hh), tmp);
#pragma unroll
            for (int j = 0; j < 8; ++j) k1[8 * hh + j] = tmp[j];
            unpack8(*(const u32x4*)(V + o + 8 * hh), tmp);
#pragma unroll
            for (int j = 0; j < 8; ++j) v[8 * hh + j] = tmp[j];
            unpack8(*(const u32x4*)(GG + o + 8 * hh), tmp);
#pragma unroll
            for (int j = 0; j < 8; ++j) g[8 * hh + j] = tmp[j]; }
        float s = 0.f, cf = 0.f;
#pragma unroll
        for (int j = 0; j < 16; ++j) { s += y[j]; cf += r[j] * (k0[j] + k1[j]) * r_k[16 * lane + j]; }
        s = quad_sum(s); cf = quad_sum(cf);
        const float mu = s * (1.f / 64.f); float q2 = 0.f;
#pragma unroll
        for (int j = 0; j < 16; ++j) { y[j] -= mu; q2 += y[j] * y[j]; }
        q2 = quad_sum(q2);
        const float rs = __builtin_amdgcn_rsqf(q2 * (1.f / 64.f) + GN_EPS);
#pragma unroll
        for (int j = 0; j < 16; ++j) y[j] = (y[j] * rs * lg[16 * lane + j] + lb[16 * lane + j] + cf * v[j]) * g[j];
        store16(YR + o, y);
    }
}

__device__ __forceinline__ void p8_route(Frame& F) {
    unsigned char* ws = F.ws; const int lane = F.lane, r = lane & 31, hh = lane >> 5, wave = F.wave;
    const bf16* H1 = (const bf16*)(ws + WS_HRES); const bf16* WF = (const bf16*)(ws + WS_WRT);
    LAS float* LG = (LAS float*)F.lds;
    LAS float* SQ = LG + 4 * 64 * 64;
    LAS int* hist = (LAS int*)(SQ + 256);
    if (F.tid < 64) hist[F.tid] = 0;
    { const int th = wave >> 2, kq = wave & 3; const int tok0 = F.vcu * 64 + th * 32;
        f32x16 a0, a1;
#pragma unroll
        for (int j = 0; j < 16; ++j) { a0[j] = 0.f; a1[j] = 0.f; }
        float sq = 0.f;
        const bf16* hp = H1 + (size_t)(tok0 + r) * DM + kq * 512 + 8 * hh;
        const bf16* wf = WF + (size_t)kq * 32 * 2048 + lane * 8;
#pragma unroll 4
        for (int s = 0; s < 32; ++s) {
            const u32x4 aw = *(const u32x4*)(hp + 16 * s); const bf16x8 a = __builtin_bit_cast(bf16x8, aw);
            { float f[8]; unpack8(aw, f);
#pragma unroll
              for (int j = 0; j < 8; ++j) sq += f[j] * f[j]; }
            const bf16x8 bh0 = *(const bf16x8*)(wf + 2048 * s), bl0 = *(const bf16x8*)(wf + 2048 * s + 512), bh1 = *(const bf16x8*)(wf + 2048 * s + 1024), bl1 = *(const bf16x8*)(wf + 2048 * s + 1536);
            a0 = __builtin_amdgcn_mfma_f32_32x32x16_bf16(a, bh0, a0, 0, 0, 0); a0 = __builtin_amdgcn_mfma_f32_32x32x16_bf16(a, bl0, a0, 0, 0, 0);
            a1 = __builtin_amdgcn_mfma_f32_32x32x16_bf16(a, bh1, a1, 0, 0, 0); a1 = __builtin_amdgcn_mfma_f32_32x32x16_bf16(a, bl1, a1, 0, 0, 0);
        }
        sq += __shfl_xor(sq, 32);
        if (hh == 0) SQ[kq * 64 + th * 32 + r] = sq;
        LAS float* lp = LG + (kq * 64 + th * 32) * 64;
#pragma unroll
        for (int j = 0; j < 16; ++j) { const int row = (j & 3) + 8 * (j >> 2) + 4 * hh; lp[row * 64 + r] = a0[j]; lp[row * 64 + 32 + r] = a1[j]; }
    }
    __syncthreads();
    int* TOPI = (int*)(ws + WS_TOPI); float* TOPG = (float*)(ws + WS_TOPG); int* WGCNT = (int*)(ws + WS_WGCNT);
    unsigned char* U8 = ws + WS_U; const float* gffn = F.in[25]; const float* brt = F.in[27];
    int mycnt = 0;
    {
        float score[8], sel[8], gs[8], gsum[8], rstd[8]; int myk[8];
#pragma unroll
        for (int q = 0; q < 8; ++q) { const int tl = wave * 8 + q;
            const float ss = (SQ[tl] + SQ[64 + tl]) + (SQ[128 + tl] + SQ[192 + tl]);
            rstd[q] = __builtin_amdgcn_rsqf(ss * (1.f / DM) + RMS_EPS);
            const float lg = ((LG[tl * 64 + lane] + LG[(64 + tl) * 64 + lane]) + (LG[(128 + tl) * 64 + lane] + LG[(192 + tl) * 64 + lane])) * rstd[q];
            score[q] = 1.0f / (1.0f + __expf(-lg)); sel[q] = score[q] + brt[lane]; gs[q] = 0.f; gsum[q] = 0.f; myk[q] = -1; }
#pragma unroll
        for (int k = 0; k < 8; ++k) {
            float bv[8]; int bi[8];
#pragma unroll
            for (int q = 0; q < 8; ++q) { bv[q] = sel[q]; bi[q] = lane; }
#define TOP8_STEP(OV, OI) { _Pragma("unroll") for (int q = 0; q < 8; ++q) { const float ov_ = (OV); const int oi_ = (OI); if (ov_ > bv[q] || (ov_ == bv[q] && oi_ < bi[q])) { bv[q] = ov_; bi[q] = oi_; } } }
            TOP8_STEP(dppf<DPP_X1>(bv[q]), dppi<DPP_X1>(bi[q]))
            TOP8_STEP(dppf<DPP_X2>(bv[q]), dppi<DPP_X2>(bi[q]))
            TOP8_STEP(dppf<DPP_HM>(bv[q]), dppi<DPP_HM>(bi[q]))
            TOP8_STEP(dppf<DPP_RM>(bv[q]), dppi<DPP_RM>(bi[q]))
#undef TOP8_STEP
#pragma unroll
            for (int o = 16; o < 64; o <<= 1) {
                float ov[8]; int oi[8];
#pragma unroll
                for (int q = 0; q < 8; ++q) { ov[q] = __shfl_xor(bv[q], o); oi[q] = __shfl_xor(bi[q], o); }
#pragma unroll
                for (int q = 0; q < 8; ++q) if (ov[q] > bv[q] || (ov[q] == bv[q] && oi[q] < bi[q])) { bv[q] = ov[q]; bi[q] = oi[q]; } }
            float sc[8];
#pragma unroll
            for (int q = 0; q < 8; ++q) sc[q] = __shfl(score[q], bi[q]);
#pragma unroll
            for (int q = 0; q < 8; ++q) { gsum[q] += sc[q]; if (lane == bi[q]) { sel[q] = -1e30f; myk[q] = k; gs[q] = sc[q]; mycnt++; } }
        }
#pragma unroll
        for (int q = 0; q < 8; ++q) { const int t = F.vcu * 64 + wave * 8 + q;
            if (myk[q] >= 0) { TOPI[t * 8 + myk[q]] = lane; TOPG[t * 8 + myk[q]] = gs[q] / gsum[q] * 2.5f; } }
        f32x4 gg[8];
#pragma unroll
        for (int j = 0; j < 8; ++j) gg[j] = ((const f32x4*)gffn + lane)[64 * j];
#pragma unroll
        for (int qb4 = 0; qb4 < 2; ++qb4) { u32x2 vw[4][8];
#pragma unroll
            for (int q = 0; q < 4; ++q) { const u32x2* xr = (const u32x2*)(H1 + (size_t)(F.vcu * 64 + wave * 8 + qb4 * 4 + q) * DM) + lane;
#pragma unroll
                for (int j = 0; j < 8; ++j) vw[q][j] = xr[64 * j]; }
#pragma unroll
            for (int q = 0; q < 4; ++q) { const float rs = rstd[qb4 * 4 + q]; unsigned* o4 = (unsigned*)(U8 + (size_t)(F.vcu * 64 + wave * 8 + qb4 * 4 + q) * DM) + lane;
#pragma unroll
                for (int j = 0; j < 8; ++j) { const f32x4 v = {bflo(vw[q][j].x), bfhi(vw[q][j].x), bflo(vw[q][j].y), bfhi(vw[q][j].y)}; o4[64 * j] = pk4_fp8(v.x * rs * gg[j].x, v.y * rs * gg[j].y, v.z * rs * gg[j].z, v.w * rs * gg[j].w); } } }
    }
    atomicAdd((int*)&hist[lane], mycnt);
    __syncthreads();
    if (F.tid < 64) WGCNT[F.vcu * 64 + F.tid] = hist[F.tid];
}

__device__ __forceinline__ void p10_slots(Frame& F) {
    unsigned char* ws = F.ws; const int tid = F.tid;
    const int* TOPI = (const int*)(ws + WS_TOPI); const float* TOPG = (const float*)(ws + WS_TOPG); const int* WGCNT = (const int*)(ws + WS_WGCNT);
    int* MISC = (int*)(ws + WS_MISC); int* STOK = (int*)(ws + WS_SLOT_TOK); int* SDST = (int*)(ws + WS_SLOT_DST); float* SG = (float*)(ws + WS_SLOT_G);
    LAS int* L = (LAS int*)F.lds;
    const int G = F.G, me = F.vcu;
    { const int e = tid & 63, part = tid >> 6; int tot = 0, bef = 0;
      for (int w = part * 32; w < part * 32 + 32 && w < G; ++w) { const int cnt = WGCNT[w * 64 + e]; tot += cnt; if (w < me) bef += cnt; }
      L[part * 64 + e] = tot; L[512 + part * 64 + e] = bef; }
    __syncthreads();
    if (tid < 64) { int tot = 0, bef = 0;
#pragma unroll
        for (int p = 0; p < 8; ++p) { tot += L[p * 64 + tid]; bef += L[512 + p * 64 + tid]; }
        L[1024 + tid] = tot; L[1088 + tid] = bef; L[1216 + tid] = (tot + 255) & ~255; }
    __syncthreads();
    if (tid == 0) { int acc = 0; for (int e = 0; e < 64; ++e) { L[1152 + e] = acc; acc += L[1216 + e]; } }
    { const int t = me * 64 + (tid >> 3); L[1280 + tid] = TOPI[t * 8 + (tid & 7)]; }
    __syncthreads();
    { const int e = L[1280 + tid]; int rank = 0;
      for (int p = 0; p < tid; ++p) rank += (L[1280 + p] == e) ? 1 : 0;
      const int slot = L[1152 + e] + L[1088 + e] + rank; const int t = me * 64 + (tid >> 3), k = tid & 7;
      STOK[slot] = t; SDST[slot] = t * 9 + k; SG[slot] = TOPG[t * 8 + k]; }
    if (tid < 64) { const int t = me * 64 + tid; STOK[RCAP + t] = t; SDST[RCAP + t] = t * 9 + 8; SG[RCAP + t] = 1.0f; }
    for (int e = me; e < 64; e += G) {
        const int s0 = L[1152 + e] + L[1024 + e], s1 = L[1152 + e] + L[1216 + e];
        for (int s = s0 + tid; s < s1; s += 512) { STOK[s] = 0; SDST[s] = -1; SG[s] = 0.f; } }
    if (me == 0) {
        if (tid < 64) { MISC[MI_TOTAL + tid] = L[1024 + tid]; MISC[MI_PADDED + tid] = L[1216 + tid]; MISC[MI_PSTART + tid] = L[1152 + tid]; }
        if (tid < 64) { const int n0 = L[1152 + tid] >> 8, cntt = L[1216 + tid] >> 8;
            for (int m = 0; m < cntt; ++m) { MISC[MI_TILE_E + n0 + m] = tid; MISC[MI_TILE_R0 + n0 + m] = L[1152 + tid] + 256 * m; }
            const int nr = (L[1152 + 63] + L[1216 + 63]) >> 8;
            MISC[MI_TILE_E + nr + tid] = 64; MISC[MI_TILE_R0 + nr + tid] = RCAP + 256 * tid;
            if (tid == 0) MISC[MI_NT] = nr + 64; }
    }
}

__device__ __forceinline__ void combine_phase(Frame& F) {
    unsigned char* ws = F.ws; const int lane = F.lane;
    const unsigned char* Y = ws + WS_Y; unsigned char* U8 = ws + WS_U; bf16* H = (bf16*)(ws + WS_HRES); const float* gple = F.in[34];
    f32x4 gg[2][4];
#pragma unroll
    for (int hf = 0; hf < 2; ++hf)
#pragma unroll
        for (int q = 0; q < 4; ++q) gg[hf][q] = *(const f32x4*)(gple + hf * 1024 + 16 * lane + 4 * q);
    for (int t = F.gw; t < NTOK; t += F.NGW) {
        u32x4 hw[2][2], yw[2][9];
#pragma unroll
        for (int hf = 0; hf < 2; ++hf) { const bf16* hp = H + (size_t)t * DM + hf * 1024 + 16 * lane; hw[hf][0] = *(const u32x4*)hp; hw[hf][1] = *(const u32x4*)(hp + 8);
#pragma unroll
            for (int k = 0; k < 9; ++k) yw[hf][k] = *(const u32x4*)(Y + ((size_t)t * 9 + k) * 2048 + hf * 1024 + 16 * lane); }
        float a[2][16]; float ss = 0.f;
#pragma unroll
        for (int hf = 0; hf < 2; ++hf) {
            bf16* hp = H + (size_t)t * DM + hf * 1024 + 16 * lane;
            { float lo8[8], hi8[8]; unpack8(hw[hf][0], lo8); unpack8(hw[hf][1], hi8);
#pragma unroll
              for (int j = 0; j < 8; ++j) { a[hf][j] = lo8[j]; a[hf][8 + j] = hi8[j]; } }
#pragma unroll
            for (int k = 0; k < 9; ++k) {
#pragma unroll
                for (int d = 0; d < 4; ++d) { const f32x2 lo = __builtin_amdgcn_cvt_pk_f32_fp8((int)yw[hf][k][d], false), hi = __builtin_amdgcn_cvt_pk_f32_fp8((int)yw[hf][k][d], true);
                    a[hf][4 * d] += lo.x * 0.0625f; a[hf][4 * d + 1] += lo.y * 0.0625f; a[hf][4 * d + 2] += hi.x * 0.0625f; a[hf][4 * d + 3] += hi.y * 0.0625f; } }
#pragma unroll
            for (int q = 0; q < 2; ++q) { u32x4 w; w.x = cvt_pk_bf16(a[hf][8 * q], a[hf][8 * q + 1]); w.y = cvt_pk_bf16(a[hf][8 * q + 2], a[hf][8 * q + 3]); w.z = cvt_pk_bf16(a[hf][8 * q + 4], a[hf][8 * q + 5]); w.w = cvt_pk_bf16(a[hf][8 * q + 6], a[hf][8 * q + 7]);
                *(u32x4*)(hp + 8 * q) = w; }
#pragma unroll
            for (int j = 0; j < 16; ++j) ss += a[hf][j] * a[hf][j];
        }
        const float rstd = __builtin_amdgcn_rsqf(wave_sum(ss) * (1.f / DM) + RMS_EPS);
#pragma unroll
        for (int hf = 0; hf < 2; ++hf) { float c[16];
#pragma unroll
            for (int j = 0; j < 16; ++j) c[j] = a[hf][j] * rstd * gg[hf][j >> 2][j & 3];
            u32x4 w; w.x = pk4_fp8(c[0], c[1], c[2], c[3]); w.y = pk4_fp8(c[4], c[5], c[6], c[7]); w.z = pk4_fp8(c[8], c[9], c[10], c[11]); w.w = pk4_fp8(c[12], c[13], c[14], c[15]);
            *(u32x4*)(U8 + (size_t)t * DM + hf * 1024 + 16 * lane) = w; }
    }
}

__device__ __forceinline__ void final_phase(Frame& F) {
    const float* g = F.in[37];
    f32x4 gg[8];
#pragma unroll
    for (int j = 0; j < 8; ++j) gg[j] = ((const f32x4*)g + F.lane)[64 * j];
    for (int m = F.gw; m < NTOK; m += 2 * F.NGW) {
        const int m2 = m + F.NGW;
        u32x2 hw[2][8];
#pragma unroll
        for (int r = 0; r < 2; ++r) { const int mm = r ? m2 : m; if (mm < NTOK) { const u32x2* hr = (const u32x2*)((const bf16*)(F.ws + WS_HRES) + (size_t)mm * DM) + F.lane;
#pragma unroll
            for (int j = 0; j < 8; ++j) hw[r][j] = hr[64 * j]; } }
#pragma unroll
        for (int r = 0; r < 2; ++r) { const int mm = r ? m2 : m; if (mm < NTOK) {
            f32x4 v[8]; float s = 0.f;
#pragma unroll
            for (int j = 0; j < 8; ++j) { v[j] = (f32x4){bflo(hw[r][j].x), bfhi(hw[r][j].x), bflo(hw[r][j].y), bfhi(hw[r][j].y)}; s += (v[j].x * v[j].x + v[j].y * v[j].y) + (v[j].z * v[j].z + v[j].w * v[j].w); }
            const float rstd = __builtin_amdgcn_rsqf(wave_sum(s) * (1.f / DM) + RMS_EPS);
            f32x4* xr = (f32x4*)(F.out + (size_t)mm * DM) + F.lane;
#pragma unroll
            for (int j = 0; j < 8; ++j) xr[64 * j] = v[j] * rstd * gg[j]; } }
    }
}

constexpr int NPHASE = 15;
__global__ void __launch_bounds__(512, 2) fwd_kernel(Args args) {
    extern __shared__ __attribute__((aligned(16))) unsigned char lds_raw[];
    Frame F;
    F.lds = (LAS unsigned char*)lds_raw; F.ws = args.ws; F.in = args.in; F.out = args.out;
    F.tid = threadIdx.x; F.lane = F.tid & 63; F.wave = __builtin_amdgcn_readfirstlane(F.tid >> 6);
    F.G = gridDim.x; { const int bx = blockIdx.x; F.vcu = (F.G % 8 == 0) ? (bx % 8) * (F.G / 8) + bx / 8 : bx; }
    F.gw = F.vcu * 8 + F.wave; F.NGW = F.G * 8;
    unsigned char* ws = args.ws;
    volatile LAS unsigned* MISCW = (volatile LAS unsigned*)(F.lds + LDSCTL_OFF);
    if (F.tid < 64) MISCW[F.tid] = 0u;
    __syncthreads();
    const int lo = args.ph_lo, hi = args.ph_hi;
    XcdBarrier bar; bar.bar = (unsigned*)(ws + WS_CTL) + CW_BAR; bar.x = 0; bar.st = nullptr;
    if (hi - lo > 1) bar = xcd_barrier_post((unsigned*)(ws + WS_CTL) + CW_BAR, MISCW + 8);
#ifdef ONLY_PHASE
#define IN(k) ((k) == ONLY_PHASE && lo <= (k) && (k) < hi)
#else
#define IN(k) (lo <= (k) && (k) < hi)
#endif
#define SEAM(k) do { if (IN(k) && IN((k) + 1)) xcd_barrier(bar); } while (0)
    using namespace pg8;
    LAS unsigned char* lds = F.lds;
    const int G = F.G, bx = (int)blockIdx.x;

    if (IN(0)) { p0_prologue(F); } SEAM(0);
    if (IN(1)) {
        { SchedDense S{ws + WS_U, 2048, ws + WS_W1, 2048, 32, 64, ZLD / 256, G, bx, 2, 0};
          EpiZ E{(bf16*)(ws + WS_Z), (unsigned*)(ws + WS_CTL) + CW_QKN};
          gemm_phase(lds, S, E); }
        {
          SchedDenseRange S{{ws + WS_U8E, 2048, ws + WS_W1G8, 2048, 16, 64, GLD / 256, G, bx, 1, 0x79797979}, bx < 128 ? 640 + bx * 3 : (bx - 128) * 5, bx < 128 ? 3 : 5};
          EpiGate E{ws + WS_GATES};
          gemm_phase<EpiGate, SchedDenseRange, true>(lds, S, E); }
    } SEAM(1);
    if (IN(2)) { p2_shift(F); } SEAM(2);
    if (IN(3)) {
#ifndef NO_LORA
        { SchedLora S{(const bf16*)(ws + WS_AP), (const bf16*)(ws + WS_WL), 0, 8, G, F.vcu, 256};
          EpiLoraW E{(bf16*)(ws + WS_WD), F.in[12]};
          gemm_phase(lds, S, E); }
        { SchedLora S{(const bf16*)(ws + WS_AP), (const bf16*)(ws + WS_WL), 8, 8, G, F.vcu, 256};
          EpiLoraA E{(bf16*)(ws + WS_KT), (bf16*)(ws + WS_BV), (const bf16*)(ws + WS_KS), (const bf16*)(ws + WS_KK), F.in[14], F.in[18]};
          gemm_phase(lds, S, E); }
        { SchedLora S{(const bf16*)(ws + WS_AP), (const bf16*)(ws + WS_WL), 16, 4, G, F.vcu, 256};
          EpiLoraG E{(bf16*)(ws + WS_G)};
          gemm_phase(lds, S, E); }
#endif
        __syncthreads();
#ifndef NO_ATTN
        attn_phase(F);
#endif
    } SEAM(3);
    if (IN(4)) { scan_phase<true>(F); } SEAM(4);
    if (IN(5)) { p5_post(F); } SEAM(5);
    if (IN(6)) {
        SchedPair S{(const bf16*)(ws + WS_YA), (const bf16*)(ws + WS_YR), 1024, 1024, (const bf16*)(ws + WS_WBR), (const bf16*)(ws + WS_WBR) + (size_t)2048 * 1024, 1024, 16, 16, 64, 8, G, bx};
        EpiMerge E{(bf16*)(ws + WS_MERGED), ws + WS_GATES};
        gemm_phase(lds, S, E);
    } SEAM(6);
    if (IN(7)) {
        SchedDense S{ws + WS_MERGED, 2048, ws + WS_WOUT, 2048, 32, 64, 8, G, bx, 2, 0};
        EpiResF32 E{(bf16*)(ws + WS_HRES), F.in[0]};
        gemm_phase(lds, S, E);
    } SEAM(7);
    if (IN(8)) { p8_route(F); } SEAM(8);
    if (IN(9)) { p10_slots(F); } SEAM(9);
    if (IN(10)) {
        SchedMoeUp S{ws + WS_U, ws + WS_WUP, (const int*)(ws + WS_SLOT_TOK), (const int*)(ws + WS_MISC), G, F.vcu, 2048, 0x79797979};
        EpiUp E{ws + WS_HB};
        gemm_phase<EpiUp, SchedMoeUp, true>(lds, S, E);
        { const int ntl = ((const int*)(ws + WS_MISC))[MI_NT] * 4, rem = ntl % G, nshort = rem ? G - rem : G;
          SchedStride S2{{ws + WS_PB, 256, ws + WS_WPP, 2048, 4, 64, 8, G, F.vcu, 2, 0}, rem ? F.vcu - rem : F.vcu, nshort};
          EpiP E2{ws + WS_PBUF};
          gemm_phase(lds, S2, E2); }
    } SEAM(10);
    if (IN(11)) {
        SchedMoeDown S{ws + WS_HB, ws + WS_WDN, (const int*)(ws + WS_MISC), G, F.vcu, 512, 0x7A7A7A7A};
        EpiDown E{ws + WS_Y, (const int*)(ws + WS_SLOT_DST), (const float*)(ws + WS_SLOT_G)};
        gemm_phase<EpiDown, SchedMoeDown, true>(lds, S, E);
    } SEAM(11);
    if (IN(12)) { combine_phase(F); } SEAM(12);
    if (IN(13)) {
        { SchedDense S{ws + WS_U, 2048, ws + WS_WPG, 2048, 16, 64, 8, G, bx, 1, 0x79797979};
          EpiPleG E{ws + WS_PBUF, (bf16*)(ws + WS_HRES)};
          gemm_phase<EpiPleG, SchedDense, true>(lds, S, E); }
    } SEAM(13);
    if (IN(14)) { final_phase(F); }
#undef IN
#undef SEAM
}

extern "C" void kernel_launch(void* const* d_in, const int* in_sizes, int n_in, void* d_out, int out_size, void* d_ws, size_t ws_size, hipStream_t stream) {
    static int grid = 0;
    if (grid == 0) {
        if (n_in != 38 || out_size != NTOK * DM || ws_size < WS_END) { fprintf(stderr, "kernel_launch: unexpected problem (n_in %d, out %d, ws %zu)\n", n_in, out_size, ws_size); grid = -1; return; }
        if (hipFuncSetAttribute((const void*)fwd_kernel, hipFuncAttributeMaxDynamicSharedMemorySize, LDS_BYTES) != hipSuccess) { fprintf(stderr, "kernel_launch: hipFuncSetAttribute failed\n"); grid = -1; return; }
        int dev = 0, cus = 0, per_cu = 0;
        (void)hipGetDevice(&dev); (void)hipDeviceGetAttribute(&cus, hipDeviceAttributeMultiprocessorCount, dev);
        (void)hipOccupancyMaxActiveBlocksPerMultiprocessor(&per_cu, (const void*)fwd_kernel, 512, LDS_BYTES);
        (void)hipGetLastError();
        if (per_cu < 1 || cus < 256) fprintf(stderr, "kernel_launch: note: occupancy %d blocks/CU, %d CUs\n", per_cu, cus);
        grid = 256;
    }
    if (grid < 0) return;
    (void)hipMemsetAsync((char*)d_ws + WS_CTL, 0, CTL_BYTES, stream);
    Args a{};
    for (int i = 0; i < 38; ++i) a.in[i] = (const float*)d_in[i];
    a.out = (float*)d_out; a.ws = (unsigned char*)d_ws;
#if MK_ONE_LAUNCH
    a.ph_lo = 0; a.ph_hi = NPHASE;
    hipLaunchKernelGGL(fwd_kernel, dim3(grid), dim3(512), LDS_BYTES, stream, a);
#else
    for (int p = 0; p < NPHASE; ++p) { a.ph_lo = p; a.ph_hi = p + 1; hipLaunchKernelGGL(fwd_kernel, dim3(grid), dim3(512), LDS_BYTES, stream, a); }
#endif
}
```

```cpp
#include <hip/hip_runtime.h>
#include <cstdio>
#include <cstdint>

#ifndef MK_ONE_LAUNCH
#define MK_ONE_LAUNCH 1
#endif

#define GAS __attribute__((address_space(1)))
#define LAS __attribute__((address_space(3)))
typedef unsigned short bf16;
typedef short bf16x8 __attribute__((ext_vector_type(8)));
typedef float f32x2 __attribute__((ext_vector_type(2)));
typedef float f32x4 __attribute__((ext_vector_type(4)));
typedef float f32x16 __attribute__((ext_vector_type(16)));
typedef unsigned u32x2 __attribute__((ext_vector_type(2)));
typedef unsigned u32x4 __attribute__((ext_vector_type(4)));

constexpr int NTOK = 16384, DM = 2048, SEQ = 2048, NB = 8;
constexpr int ZLD = 6656;
constexpr int ZR = 3072;
constexpr int RC = 3488;
constexpr int GLD = 4096;
constexpr int N1 = ZLD + GLD;
constexpr int NEXP = 64, TOPK = 8, EFF = 512;
constexpr int RCAP = 147456;
constexpr int SLOTS = RCAP + NTOK;
constexpr float RMS_EPS = 1e-6f, GN_EPS = 64e-5f;
constexpr float LOG2E = 1.4426950408889634f;

constexpr size_t MiB = 1u << 20;
constexpr size_t WS_CTL = 0, CTL_BYTES = 1 * MiB;
constexpr size_t WS_TOPI = 1 * MiB, WS_TOPG = WS_TOPI + 512 * 1024, WS_WGCNT = 2 * MiB, WS_MISC = WS_WGCNT + 64 * 1024;
constexpr size_t WS_SLOT_TOK = 3 * MiB, WS_SLOT_DST = 4 * MiB, WS_SLOT_G = 5 * MiB;
constexpr size_t WS_WRT = 7 * MiB, WS_WL = 8 * MiB, WL_BYTES = 5120 * 256 * 2;
constexpr size_t WS_PB = 11 * MiB, WS_WPP = 19 * MiB, WS_WPG = 27 * MiB, WS_WOUT = 35 * MiB, WS_WBR = 43 * MiB, WS_W1 = 51 * MiB;
constexpr size_t WS_Z = 93 * MiB, WS_U = 301 * MiB;
constexpr size_t WS_WUP = 93 * MiB, WS_WDN = 223 * MiB, WS_YR = 288 * MiB;
constexpr size_t WS_GATES = 365 * MiB, WS_YA = 493 * MiB, WS_R = 525 * MiB, WS_V = 557 * MiB, WS_KK = 589 * MiB, WS_WD = 621 * MiB, WS_KT = 749 * MiB, WS_BV = 813 * MiB, WS_G = 877 * MiB;
constexpr size_t WS_KS = 909 * MiB, WS_AP = 941 * MiB, WS_VT = 957 * MiB;
constexpr size_t WS_YS = 909 * MiB, WS_MERGED = 621 * MiB;
constexpr size_t WS_HRES = 877 * MiB  , WS_HB = 365 * MiB, WS_Y = 445 * MiB  , WS_PBUF = 749 * MiB;
constexpr size_t WS_END = 1037 * MiB;
constexpr size_t WS_W1G8 = WS_W1 + (size_t)ZLD * 2048 * 2;
constexpr size_t WS_U8E = WS_R;
constexpr int MI_TOTAL = 0, MI_PADDED = 64, MI_PSTART = 128, MI_NT = 192, MI_TILE_E = 1024, MI_TILE_R0 = 2048;
constexpr int CW_BAR = 4096, CW_QKN = 1024;

constexpr int RING_BYTES = 131072, LDSCTL_OFF = 143360, LDS_BYTES = 147456;

__device__ __forceinline__ unsigned cvt_pk_bf16(float lo, float hi) { unsigned r; asm("v_cvt_pk_bf16_f32 %0, %1, %2" : "=v"(r) : "v"(lo), "v"(hi)); return r; }
typedef __bf16 bf16x2v __attribute__((ext_vector_type(2)));
__device__ __forceinline__ unsigned cvt_pk_bf16_hz(float lo, float hi) { return __builtin_bit_cast(unsigned, __builtin_convertvector((f32x2){lo, hi}, bf16x2v)); }
__device__ __forceinline__ float bflo(unsigned w) { return __builtin_bit_cast(float, w << 16); }
__device__ __forceinline__ float bfhi(unsigned w) { return __builtin_bit_cast(float, w & 0xffff0000u); }
__device__ __forceinline__ float ex2(float x) { return __builtin_amdgcn_exp2f(x); }
__device__ __forceinline__ float sigm(float x) { return __builtin_amdgcn_rcpf(1.0f + ex2(-x * LOG2E)); }
constexpr int DPP_X1 = 0xB1, DPP_X2 = 0x4E, DPP_HM = 0x141, DPP_RM = 0x140;
template <int CTRL> __device__ __forceinline__ float dppf(float x) { return __builtin_bit_cast(float, __builtin_amdgcn_update_dpp(0, __builtin_bit_cast(int, x), CTRL, 0xf, 0xf, false)); }
template <int CTRL> __device__ __forceinline__ int dppi(int x) { return __builtin_amdgcn_update_dpp(0, x, CTRL, 0xf, 0xf, false); }
__device__ __forceinline__ float quad_sum(float v) { v += dppf<DPP_X1>(v); v += dppf<DPP_X2>(v); return v; }
__device__ __forceinline__ float row16_sum(float v) { v += dppf<DPP_X1>(v); v += dppf<DPP_X2>(v); v += dppf<DPP_HM>(v); v += dppf<DPP_RM>(v); return v; }
__device__ __forceinline__ float row16_max(float v) { v = fmaxf(v, dppf<DPP_X1>(v)); v = fmaxf(v, dppf<DPP_X2>(v)); v = fmaxf(v, dppf<DPP_HM>(v)); v = fmaxf(v, dppf<DPP_RM>(v)); return v; }
__device__ __forceinline__ float wave_sum(float v) { v = row16_sum(v); v += __shfl_xor(v, 16); v += __shfl_xor(v, 32); return v; }
__device__ __forceinline__ void unpack8(const u32x4 w, float (&f)[8]) { f[0] = bflo(w.x); f[1] = bfhi(w.x); f[2] = bflo(w.y); f[3] = bfhi(w.y); f[4] = bflo(w.z); f[5] = bfhi(w.z); f[6] = bflo(w.w); f[7] = bfhi(w.w); }
__device__ __forceinline__ u32x4 pack8(const float (&f)[8]) { u32x4 w; w.x = cvt_pk_bf16(f[0], f[1]); w.y = cvt_pk_bf16(f[2], f[3]); w.z = cvt_pk_bf16(f[4], f[5]); w.w = cvt_pk_bf16(f[6], f[7]); return w; }
#define dpp_f(v, ctrl) __builtin_bit_cast(float, __builtin_amdgcn_update_dpp(__builtin_bit_cast(int, (v)), __builtin_bit_cast(int, (v)), (ctrl), 0xF, 0xF, true))
#define PIN(x) asm("" : "+v"(x))
__device__ __forceinline__ void fmac_(float& acc, float a, float b) { asm("v_fmac_f32 %0, %1, %2" : "+v"(acc) : "v"(a), "v"(b)); }
__device__ __forceinline__ float fmul_(float a, float b) { float r; asm("v_mul_f32 %0, %1, %2" : "=v"(r) : "v"(a), "v"(b)); return r; }
__device__ __forceinline__ float fma3_(float a, float b, float c) { float r; asm("v_fma_f32 %0, %1, %2, %3" : "=v"(r) : "v"(a), "v"(b), "v"(c)); return r; }
__device__ __forceinline__ unsigned pk4_fp8(float a, float b, float c, float d) { int w = 0; w = __builtin_amdgcn_cvt_pk_fp8_f32(a, b, w, false); w = __builtin_amdgcn_cvt_pk_fp8_f32(c, d, w, true); return (unsigned)w; }
#define LDS_WAIT() asm volatile("s_waitcnt lgkmcnt(0)" ::: "memory")
#define VM_WAIT() asm volatile("s_waitcnt vmcnt(0)" ::: "memory")

#define XB_TMO      128
#define XB_XCNT(j)  (256  + 64 * (j))
#define XB_XSUB(j)  (1280 + 64 * (j))
#define XB_XGEN(j)  (2304 + 64 * (j))
#define XB_TOP      3328
#define XB_TOPGEN   3392
#define XCD_BAR_WORDS 3456
#define XB_SPIN_CAP (1u << 22)
__device__ __forceinline__ unsigned xb_ld(unsigned* p)              { return __hip_atomic_load(p, __ATOMIC_RELAXED, __HIP_MEMORY_SCOPE_AGENT); }
__device__ __forceinline__ unsigned xb_add(unsigned* p, unsigned v) { return __hip_atomic_fetch_add(p, v, __ATOMIC_RELAXED, __HIP_MEMORY_SCOPE_AGENT); }
__device__ __forceinline__ unsigned xb_xcc_id() { return (unsigned)__builtin_amdgcn_s_getreg((3 << 11) | 20) & 0xFu; }
#define XB_SPIN(cond, bar) do { unsigned _sp = 0; while (cond) { __builtin_amdgcn_s_sleep(1); \
    if ((++_sp & 255u) == 0u) { if (xb_ld(&(bar)[XB_TMO])) break; if (_sp > XB_SPIN_CAP) { atomicAdd(&(bar)[XB_TMO], 1u); break; } } } } while (0)
struct XcdBarrier { unsigned* bar; unsigned x; volatile LAS unsigned* st; };
__device__ __forceinline__ XcdBarrier xcd_barrier_post(unsigned* bar, volatile LAS unsigned* st) {
    XcdBarrier b; b.bar = bar; b.x = xb_xcc_id(); b.st = st;
    if (threadIdx.x == 0) (void)xb_add(&bar[XB_XCNT(b.x)], 1u);
    return b;
}
__device__ __forceinline__ void xcd_barrier_complete(unsigned* bar, unsigned x, unsigned& nloc, unsigned& nx) {
    const unsigned G = gridDim.x * gridDim.y * gridDim.z;
    unsigned sum, cnt, mine, sp = 0u;
    for (;;) {
        sum = 0u; cnt = 0u; mine = 0u;
#pragma unroll
        for (unsigned j = 0; j < 16; ++j) { const unsigned c = xb_ld(&bar[XB_XCNT(j)]); sum += c; cnt += (c > 0u) ? 1u : 0u; mine = (j == x) ? c : mine; }
        if (sum == G) break;
        __builtin_amdgcn_s_sleep(1);
        if ((++sp & 255u) == 0u) { if (xb_ld(&bar[XB_TMO])) break; if (sp > XB_SPIN_CAP) { atomicAdd(&bar[XB_TMO], 1u); break; } }
    }
    nloc = mine > 0u ? mine : 1u; nx = cnt > 0u ? cnt : 1u;
}
__device__ __forceinline__ void xcd_barrier(const XcdBarrier& b) {
    asm volatile("s_waitcnt vmcnt(0)" ::: "memory");
    __syncthreads();
    if (threadIdx.x == 0) {
        unsigned* bar = b.bar;
        __builtin_amdgcn_s_waitcnt(0);
        unsigned nloc = b.st[0], nx = b.st[1];
        if (nloc == 0u) { xcd_barrier_complete(bar, b.x, nloc, nx); b.st[0] = nloc; b.st[1] = nx; }
        const unsigned old = xb_add(&bar[XB_XSUB(b.x)], 1u);
        const unsigned gen = old / nloc;
        if (old + 1u == (gen + 1u) * nloc) {
            __builtin_amdgcn_fence(__ATOMIC_RELEASE, "agent");
            asm volatile("s_waitcnt vmcnt(0)" ::: "memory");
            const unsigned og = xb_add(&bar[XB_TOP], 1u);
            const unsigned tg = og / nx;
            if (og + 1u == (tg + 1u) * nx) xb_add(&bar[XB_TOPGEN], 1u);
            else XB_SPIN(xb_ld(&bar[XB_TOPGEN]) == tg, bar);
            __builtin_amdgcn_fence(__ATOMIC_ACQUIRE, "agent");
            xb_add(&bar[XB_XGEN(b.x)], 1u);
            asm volatile("s_waitcnt vmcnt(0)" ::: "memory");
        } else {
            XB_SPIN(xb_ld(&bar[XB_XGEN(b.x)]) == gen, bar);
            __builtin_amdgcn_fence(__ATOMIC_ACQUIRE, "agent");
            asm volatile("s_waitcnt vmcnt(0)" ::: "memory");
        }
    }
    __syncthreads();
}

namespace pg8 {
constexpr int BM = 256, BK = 64, HALF = 128, HTB = HALF * BK * 2, STAGE_BYTES = 8 * HTB, NXCD = 8, WGM = 8;
__device__ __forceinline__ int lds_byte(int r, int c) { const int st = (r >> 4) * 2 + (c >> 5), rr = r & 15, cc = c & 31, ob = rr * 64 + cc * 2; return st * 1024 + (ob ^ (((ob >> 9) & 1) << 5)); }
__device__ __forceinline__ void stage_rc(int b, int& R, int& C) { const int st = b / 1024, sb = b % 1024, swz = sb ^ (((sb >> 9) & 1) << 5); R = (st >> 1) * 16 + swz / 64; C = (st & 1) * 32 + (swz % 64) / 2; }
__device__ __forceinline__ int perm32(int rho) { const int n = rho >> 4, i = rho & 15; return 8 * (i >> 2) + 4 * n + (i & 3); }
struct Unit { int pm, pn, s, x; };
__device__ __forceinline__ void static_tile(int L, int nM, int nN, int& pm, int& pn) {
    const int nwg = nM * nN; int wgid = L;
    { const int q = nwg / NXCD, r = nwg % NXCD, xcd = wgid % NXCD, off = wgid / NXCD; wgid = (xcd < r ? xcd * (q + 1) : r * (q + 1) + (xcd - r) * q) + off; }
    const int nig = WGM * nN, gid = wgid / nig, fm = gid * WGM, gsz = (nM - fm) < WGM ? (nM - fm) : WGM;
    pm = fm + ((wgid % nig) % gsz); pn = (wgid % nig) / gsz;
}
typedef int v8i __attribute__((ext_vector_type(8)));
template <class Epi, class Sched, bool FP8 = false>
__device__ __forceinline__ void gemm_phase(LAS unsigned char* lds, const Sched& S, const Epi& E) {
    int tid = threadIdx.x; asm volatile("" : "+v"(tid));
    const int wid = __builtin_amdgcn_readfirstlane(tid >> 6), lane = tid & 63, wr = wid >> 2, wc = wid & 3, fr = lane & 15, fq = lane >> 4;
    const int ldb = S.ldb;
    int RA[2]; unsigned CA2[2], voffB[2];
#pragma unroll
    for (int i = 0; i < 2; ++i) { int R, C; stage_rc(tid * 16 + i * 8192, R, C); const int Rb = (R & ~31) + perm32(R & 31);
        RA[i] = R; CA2[i] = (unsigned)C * 2u; voffB[i] = FP8 ? (unsigned)(Rb * ldb + C * 2) : (unsigned)(Rb * ldb + C) * 2u; }
    const size_t kstep = (size_t)(BK * 2);
    const size_t hstepB = FP8 ? (size_t)HALF * ldb : (size_t)HALF * ldb * 2;
    const unsigned ldsw = (unsigned)wid * 1024u;
    const int aoff = lds_byte(wr * 64 + fr, fq * 8), boff = lds_byte(wc * 32 + fr, fq * 8);
#define PG8_SA(b, h) (((b) * 2 + (h)) * HTB)
#define PG8_SB(b, h) ((4 + (b) * 2 + (h)) * HTB)
#define PG8_STAGE(bufoff, gbase, voff) do { _Pragma("unroll") for (int _i = 0; _i < 2; ++_i) \
        __builtin_amdgcn_global_load_lds((const unsigned*)((const char*)(gbase) + (voff)[_i]), (LAS unsigned*)(lds + (bufoff) + ldsw + _i * 8192), 16, 0, 0); } while (0)
#define PG8_LD8(p) __builtin_bit_cast(v8i, __builtin_shufflevector(*(const LAS u32x4*)(p), *(const LAS u32x4*)((p) + 1024), 0, 1, 2, 3, 4, 5, 6, 7))
#define PG8_LDA(dst, b, h) do { if constexpr (FP8) { _Pragma("unroll") for (int m = 0; m < 4; ++m) dst##8[m] = PG8_LD8(lds + PG8_SA(b, h) + aoff + m * 2048); } \
        else { _Pragma("unroll") for (int m = 0; m < 4; ++m) _Pragma("unroll") for (int k = 0; k < 2; ++k) dst[m][k] = *(const LAS bf16x8*)(lds + PG8_SA(b, h) + aoff + m * 2048 + k * 1024); } } while (0)
#define PG8_LDB(dst, b, h) do { if constexpr (FP8) { _Pragma("unroll") for (int n = 0; n < 2; ++n) dst##8[n] = PG8_LD8(lds + PG8_SB(b, h) + boff + n * 2048); } \
        else { _Pragma("unroll") for (int n = 0; n < 2; ++n) _Pragma("unroll") for (int k = 0; k < 2; ++k) dst[n][k] = *(const LAS bf16x8*)(lds + PG8_SB(b, h) + boff + n * 2048 + k * 1024); } } while (0)
#define PG8_MMA(ai, bj, At, Bt) do { __builtin_amdgcn_s_setprio(1); _Pragma("unroll") for (int m = 0; m < 4; ++m) _Pragma("unroll") for (int n = 0; n < 2; ++n) { \
        if constexpr (FP8) asm volatile("v_mfma_scale_f32_16x16x128_f8f6f4 %0, %1, %2, %0, %3, %4 op_sel_hi:[0,0,0]" : "+v"(acc[ai][bj][m][n]) : "v"(Bt##8[n]), "v"(At##8[m]), "v"(wscale), "v"(ascale)); \
        else { _Pragma("unroll") for (int k = 0; k < 2; ++k) acc[ai][bj][m][n] = __builtin_amdgcn_mfma_f32_16x16x32_bf16(Bt[n][k], At[m][k], acc[ai][bj][m][n], 0, 0, 0); } } __builtin_amdgcn_s_setprio(0); } while (0)
#define PG8_WAIT_V(n) asm volatile("s_waitcnt vmcnt(" #n ")" ::: "memory")
#define PG8_WAIT_L(n) asm volatile("s_waitcnt lgkmcnt(" #n ")" ::: "memory")
#define PG8_BAR __builtin_amdgcn_s_barrier()
#define PG8_SCHED __builtin_amdgcn_sched_barrier(0)
    Unit cur, nxt; int ui = 0;
    if (!S.next(0, cur)) return;
    int wscale = 0x7F7F7F7F, ascale = 0x7F7F7F7F; if constexpr (FP8) wscale = S.wscale;
    f32x4 acc[2][2][4][2];
#pragma unroll
    for (int a = 0; a < 2; ++a)
#pragma unroll
        for (int b = 0; b < 2; ++b)
#pragma unroll
            for (int m = 0; m < 4; ++m)
#pragma unroll
                for (int n = 0; n < 2; ++n) acc[a][b][m][n] = (f32x4){0.f, 0.f, 0.f, 0.f};
    bf16x8 At[4][2], B0[2][2], B1[2][2]; v8i At8[4], B08[2], B18[2];
    unsigned vC[2][2], vN[2][2];
#pragma unroll
    for (int h = 0; h < 2; ++h)
#pragma unroll
        for (int i = 0; i < 2; ++i) vC[h][i] = S.arow(cur, h * HALF + RA[i]) + CA2[i];
    const char* cA = S.aptr(cur); const char* cB = S.bptr(cur);
    PG8_STAGE(PG8_SB(0, 0), cB, voffB); PG8_STAGE(PG8_SB(0, 1), cB + hstepB, voffB); PG8_STAGE(PG8_SA(0, 0), cA, vC[0]); PG8_STAGE(PG8_SA(0, 1), cA, vC[1]);
    if (wr == 1) PG8_BAR;
    PG8_WAIT_V(2); PG8_BAR;
    PG8_STAGE(PG8_SB(1, 0), cB + kstep, voffB); PG8_STAGE(PG8_SA(1, 0), cA + kstep, vC[0]); PG8_STAGE(PG8_SB(1, 1), cB + hstepB + kstep, voffB);
    PG8_WAIT_V(6); PG8_BAR;
    for (;;) {
        const bool has_next = S.next(ui + 1, nxt);
        const char* nA = cA; const char* nB = cB;
        if constexpr (Sched::VARROW) {
#pragma unroll
            for (int h = 0; h < 2; ++h)
#pragma unroll
                for (int i = 0; i < 2; ++i) vN[h][i] = vC[h][i]; }
        if (has_next) { nA = S.aptr(nxt); nB = S.bptr(nxt);
            if constexpr (Sched::VARROW) {
#pragma unroll
                for (int h = 0; h < 2; ++h)
#pragma unroll
                    for (int i = 0; i < 2; ++i) vN[h][i] = S.arow(nxt, h * HALF + RA[i]) + CA2[i]; } }
        const int nt = S.nt(cur);
#pragma nounroll
        for (int t = 0; t < nt; t += 2) {
            const bool last = (t == nt - 2);
            const char* a1 = cA + (size_t)(t + 1) * kstep;
            const char* a2 = last ? nA : cA + (size_t)(t + 2) * kstep; const char* b2 = last ? nB : cB + (size_t)(t + 2) * kstep;
            const char* a3 = a2 + kstep; const char* b3 = b2 + kstep;
            unsigned v2[2][2];
#pragma unroll
            for (int h = 0; h < 2; ++h)
#pragma unroll
                for (int i = 0; i < 2; ++i) { if constexpr (Sched::VARROW) v2[h][i] = last ? vN[h][i] : vC[h][i]; else v2[h][i] = vC[h][i]; }
            PG8_LDB(B0, 0, 0); PG8_LDB(B1, 0, 1); PG8_SCHED; PG8_LDA(At, 0, 0); PG8_STAGE(PG8_SA(1, 1), a1, vC[1]);
            PG8_WAIT_V(8); PG8_WAIT_L(0); PG8_BAR; PG8_MMA(0, 0, At, B0); PG8_MMA(0, 1, At, B1); PG8_BAR; PG8_SCHED;
            PG8_LDA(At, 0, 1); PG8_STAGE(PG8_SB(0, 0), b2, voffB); PG8_STAGE(PG8_SB(0, 1), b2 + hstepB, voffB); PG8_STAGE(PG8_SA(0, 0), a2, v2[0]);
            PG8_WAIT_V(8); PG8_WAIT_L(0); PG8_BAR; PG8_MMA(1, 0, At, B0); PG8_MMA(1, 1, At, B1); PG8_BAR; PG8_SCHED;
            PG8_LDB(B0, 1, 0); PG8_LDB(B1, 1, 1); PG8_SCHED; PG8_LDA(At, 1, 0); PG8_STAGE(PG8_SA(0, 1), a2, v2[1]);
            PG8_WAIT_V(8); PG8_WAIT_L(0); PG8_BAR; PG8_MMA(0, 0, At, B0); PG8_MMA(0, 1, At, B1); PG8_BAR; PG8_SCHED;
            PG8_LDA(At, 1, 1); PG8_STAGE(PG8_SB(1, 0), b3, voffB); PG8_STAGE(PG8_SB(1, 1), b3 + hstepB, voffB); PG8_STAGE(PG8_SA(1, 0), a3, v2[0]);
            PG8_WAIT_V(8); PG8_WAIT_L(0); PG8_BAR; PG8_MMA(1, 0, At, B0); PG8_MMA(1, 1, At, B1); PG8_BAR; PG8_SCHED;
        }
        if (wr == 0) PG8_BAR;
        if constexpr (FP8) asm volatile("s_nop 15\n\ts_nop 15\n\ts_nop 15\n\ts_nop 15\n\ts_nop 15\n\ts_nop 15" ::: "memory");
        E(acc, cur, wr, wc, fr, fq);
        if (!has_next) break;
#pragma unroll
        for (int a = 0; a < 2; ++a)
#pragma unroll
            for (int b = 0; b < 2; ++b)
#pragma unroll
                for (int m = 0; m < 4; ++m)
#pragma unroll
                    for (int n = 0; n < 2; ++n) acc[a][b][m][n] = (f32x4){0.f, 0.f, 0.f, 0.f};
        cur = nxt; cA = nA; cB = nB; ++ui;
        if constexpr (Sched::VARROW) {
#pragma unroll
            for (int h = 0; h < 2; ++h)
#pragma unroll
                for (int i = 0; i < 2; ++i) vC[h][i] = vN[h][i]; }
        if (wr == 1) PG8_BAR;
    }
    PG8_WAIT_V(0);
    PG8_BAR;
#undef PG8_SA
#undef PG8_SB
#undef PG8_STAGE
#undef PG8_LDA
#undef PG8_LDB
#undef PG8_MMA
#undef PG8_LD8
#undef PG8_WAIT_V
#undef PG8_WAIT_L
#undef PG8_BAR
#undef PG8_SCHED
}

struct SchedDense {
    static constexpr bool VARROW = false;
    const void* A; int lda; const void* Bt; int ldb; int ntk; int nM, nN, G, c; int esz; int wscale;
    __device__ __forceinline__ bool next(int i, Unit& u) const { const int L = i * G + c; if (L >= nM * nN) return false; static_tile(L, nM, nN, u.pm, u.pn); u.s = 0; u.x = 0; return true; }
    __device__ __forceinline__ int nt(const Unit&) const { return ntk; }
    __device__ __forceinline__ const char* aptr(const Unit& u) const { return (const char*)A + (size_t)u.pm * BM * lda * esz; }
    __device__ __forceinline__ unsigned arow(const Unit&, int r) const { return (unsigned)(r * lda * esz); }
    __device__ __forceinline__ const char* bptr(const Unit& u) const { return (const char*)Bt + (size_t)u.pn * BM * ldb * esz; }
};
struct SchedDenseRange : SchedDense {
    int base, cnt;
    __device__ __forceinline__ bool next(int i, Unit& u) const { if (i >= cnt) return false; static_tile(base + i, nM, nN, u.pm, u.pn); u.s = 0; u.x = 0; return true; }
};
struct SchedStride : SchedDense {
    int first, stride;
    __device__ __forceinline__ bool next(int i, Unit& u) const { const int L = first + i * stride; if (first < 0 || L >= nM * nN) return false; u.pm = L / nN; u.pn = L % nN; u.s = 0; u.x = 0; return true; }
};
struct SchedPair {
    static constexpr bool VARROW = true;
    const bf16* A0; const bf16* A1; int lda0, lda1; const bf16* B0; const bf16* B1; int ldb; int nt0, nt1; int nM, nN, G, c;
    __device__ __forceinline__ bool next(int i, Unit& u) const { const int L = (i >> 1) * G + c; if (L >= nM * nN) return false; static_tile(L, nM, nN, u.pm, u.pn); u.s = i & 1; u.x = 0; return true; }
    __device__ __forceinline__ int nt(const Unit& u) const { return u.s ? nt1 : nt0; }
    __device__ __forceinline__ const char* aptr(const Unit& u) const { return u.s ? (const char*)A1 + (size_t)u.pm * BM * lda1 * 2 : (const char*)A0 + (size_t)u.pm * BM * lda0 * 2; }
    __device__ __forceinline__ unsigned arow(const Unit& u, int r) const { return (unsigned)(r * (u.s ? lda1 : lda0) * 2); }
    __device__ __forceinline__ const char* bptr(const Unit& u) const { return (const char*)(u.s ? B1 : B0) + (size_t)u.pn * BM * ldb * 2; }
};
struct SchedLora {
    static constexpr bool VARROW = false;
    const bf16* A; const bf16* Bt; int pn0, npn; int G, c;
    int ldb;
    __device__ __forceinline__ bool next(int i, Unit& u) const { const int L = i * G + c; if (L >= 64 * npn) return false; u.pm = L / npn; u.pn = pn0 + L % npn; u.s = 0; u.x = 0; return true; }
    __device__ __forceinline__ int nt(const Unit&) const { return 4; }
    __device__ __forceinline__ const char* aptr(const Unit& u) const { return (const char*)A + (size_t)u.pm * BM * 512 * 2 + (u.pn >= 16 ? 512 : 0); }
    __device__ __forceinline__ unsigned arow(const Unit&, int r) const { return (unsigned)(r * 1024); }
    __device__ __forceinline__ const char* bptr(const Unit& u) const { return (const char*)Bt + (size_t)u.pn * BM * 256 * 2; }
};
struct SchedMoeUp {
    static constexpr bool VARROW = true;
    const unsigned char* U; const unsigned char* Wup; const int* slot_tok; const int* misc; int G, c; int ldb; int wscale;
    __device__ __forceinline__ bool next(int i, Unit& u) const { const int L = i * G + c; const int nt_ = misc[MI_NT]; if (L >= nt_ * 4) return false; u.pm = L >> 2; u.pn = L & 3; u.x = misc[MI_TILE_E + u.pm]; u.s = misc[MI_TILE_R0 + u.pm]; return true; }
    __device__ __forceinline__ int nt(const Unit&) const { return 16; }
    __device__ __forceinline__ const char* aptr(const Unit&) const { return (const char*)U; }
    __device__ __forceinline__ unsigned arow(const Unit& u, int r) const { return (unsigned)slot_tok[u.s + r] * 2048u; }
    __device__ __forceinline__ const char* bptr(const Unit& u) const { return (const char*)Wup + ((size_t)u.x * 1024 + (size_t)u.pn * 256) * 2048; }
};
struct SchedMoeDown {
    static constexpr bool VARROW = false;
    const unsigned char* H; const unsigned char* Wdn; const int* misc; int G, c; int ldb; int wscale;
    __device__ __forceinline__ bool next(int i, Unit& u) const { const int L = i * G + c; const int nt_ = misc[MI_NT]; if (L >= nt_ * 8) return false; u.pm = L >> 3; u.pn = L & 7; u.x = misc[MI_TILE_E + u.pm]; u.s = misc[MI_TILE_R0 + u.pm]; return true; }
    __device__ __forceinline__ int nt(const Unit&) const { return 4; }
    __device__ __forceinline__ const char* aptr(const Unit& u) const { return (const char*)H + (size_t)u.s * 512; }
    __device__ __forceinline__ unsigned arow(const Unit&, int r) const { return (unsigned)(r * 512); }
    __device__ __forceinline__ const char* bptr(const Unit& u) const { return (const char*)Wdn + ((size_t)u.x * 2048 + (size_t)u.pn * 256) * 512; }
};

#define EPI_ROWS_BEGIN _Pragma("unroll") for (int ai = 0; ai < 2; ++ai) _Pragma("unroll") for (int m = 0; m < 4; ++m) { const int rl = ai * HALF + wr * 64 + m * 16 + fr;
#define EPI_ROWS_END }
#define EPI_HROWS_BEGIN _Pragma("unroll") for (int m = 0; m < 4; ++m) { const int rl = ai * HALF + wr * 64 + m * 16 + fr;
struct EpiZ {
    bf16* Z; unsigned* QKN;
    __device__ __forceinline__ void operator()(const f32x4 (&acc)[2][2][4][2], const Unit& u, int wr, int wc, int fr, int fq) const {
        const int cl = u.pn * BM + wc * 32 + 8 * fq;
        EPI_ROWS_BEGIN
            bf16* rowp = Z + ((size_t)u.pm * BM + rl) * ZLD + cl;
#pragma unroll
            for (int bj = 0; bj < 2; ++bj) { const f32x4 v0 = acc[ai][bj][m][0], v1 = acc[ai][bj][m][1];
                u32x4 w; w.x = cvt_pk_bf16_hz(v0[0], v0[1]); w.y = cvt_pk_bf16_hz(v0[2], v0[3]); w.z = cvt_pk_bf16_hz(v1[0], v1[1]); w.w = cvt_pk_bf16_hz(v1[2], v1[3]);
                *(u32x4*)(rowp + bj * HALF) = w; }
        EPI_ROWS_END
        if (u.pn < 8) {
#pragma unroll
            for (int bj = 0; bj < 2; ++bj) { float nm = 0.f;
                EPI_ROWS_BEGIN
                    const f32x4 v0 = acc[ai][bj][m][0], v1 = acc[ai][bj][m][1];
                    float ss = v0[0] * v0[0] + v0[1] * v0[1] + v0[2] * v0[2] + v0[3] * v0[3] + v1[0] * v1[0] + v1[1] * v1[1] + v1[2] * v1[2] + v1[3] * v1[3];
                    ss += __shfl_xor(ss, 16); ss += __shfl_xor(ss, 32); nm = fmaxf(nm, ss); (void)rl;
                EPI_ROWS_END
                nm = row16_max(nm);
                if (fr == 0 && fq == 0) atomicMax(QKN + (u.pm >> 3) * 64 + ((u.pn * BM + wc * 32 + bj * HALF) >> 5), __float_as_uint(nm)); }
        }
    }
};
__device__ __forceinline__ unsigned pk4_u8(float a, float b, float c, float d) {
    return (unsigned)(a * 255.0f + 0.5f) | ((unsigned)(b * 255.0f + 0.5f) << 8) | ((unsigned)(c * 255.0f + 0.5f) << 16) | ((unsigned)(d * 255.0f + 0.5f) << 24); }
struct EpiGate {
    unsigned char* GT;
    __device__ __forceinline__ void operator()(const f32x4 (&acc)[2][2][4][2], const Unit& u, int wr, int wc, int fr, int fq) const {
        const int cl = u.pn * BM + wc * 32 + 8 * fq;
        EPI_ROWS_BEGIN
            unsigned char* rowp = GT + ((size_t)u.pm * BM + rl) * GLD + cl;
#pragma unroll
            for (int bj = 0; bj < 2; ++bj) { f32x4 v0 = acc[ai][bj][m][0], v1 = acc[ai][bj][m][1];
#pragma unroll
                for (int j = 0; j < 4; ++j) { v0[j] = sigm(v0[j]); v1[j] = sigm(v1[j]); }
                u32x2 w; w.x = pk4_u8(v0[0], v0[1], v0[2], v0[3]); w.y = pk4_u8(v1[0], v1[1], v1[2], v1[3]);
                *(u32x2*)(rowp + bj * HALF) = w; }
        EPI_ROWS_END
    }
};
struct EpiLoraW {
    bf16* DD; const float* w0;
    __device__ __forceinline__ void operator()(const f32x4 (&acc)[2][2][4][2], const Unit& u, int wr, int wc, int fr, int fq) const {
        const int d = (u.pn >> 2) & 1, cb = (u.pn & 3) * BM + wc * 32 + 8 * fq;
#pragma unroll
        for (int bj = 0; bj < 2; ++bj) { const int c = cb + bj * HALF;
            const f32x4 b0 = *(const f32x4*)(w0 + d * 1024 + c), b1 = *(const f32x4*)(w0 + d * 1024 + c + 4);
            EPI_ROWS_BEGIN
                const size_t row = (size_t)u.pm * BM + rl; f32x4 v0 = acc[ai][bj][m][0], v1 = acc[ai][bj][m][1];
#pragma unroll
                for (int j = 0; j < 4; ++j) { v0[j] = 1.0f - ex2(-0.60653065971f * LOG2E * sigm(v0[j] + b0[j])); v1[j] = 1.0f - ex2(-0.60653065971f * LOG2E * sigm(v1[j] + b1[j])); }
                u32x4 w; w.x = cvt_pk_bf16(v0[0], v0[1]); w.y = cvt_pk_bf16(v0[2], v0[3]); w.z = cvt_pk_bf16(v1[0], v1[1]); w.w = cvt_pk_bf16(v1[2], v1[3]);
                *(u32x4*)(DD + ((size_t)d * NTOK + row) * 1024 + c) = w;
            EPI_ROWS_END }
    }
};
struct EpiLoraA {
    bf16* KT; bf16* BV; const bf16* KS; const bf16* KK; const float* a0; const float* k_a;
    __device__ __forceinline__ void operator()(const f32x4 (&acc)[2][2][4][2], const Unit& u, int wr, int wc, int fr, int fq) const {
        const int d = (u.pn >> 2) & 1, cb = (u.pn & 3) * BM + wc * 32 + 8 * fq;
#pragma unroll
        for (int bj = 0; bj < 2; ++bj) { const int c = cb + bj * HALF;
            const f32x4 b0 = *(const f32x4*)(a0 + d * 1024 + c), b1 = *(const f32x4*)(a0 + d * 1024 + c + 4);
            const f32x4 ka0 = *(const f32x4*)(k_a + c), ka1 = *(const f32x4*)(k_a + c + 4);
#pragma unroll
            for (int ai = 0; ai < 2; ++ai) {
            u32x4 ksw[4], kkw[4];
            EPI_HROWS_BEGIN
                const size_t row = (size_t)u.pm * BM + rl; ksw[m] = *(const u32x4*)(KS + row * 1024 + c); kkw[m] = *(const u32x4*)(KK + row * 1024 + c);
            EPI_ROWS_END
            EPI_HROWS_BEGIN
                const size_t row = (size_t)u.pm * BM + rl; const f32x4 v0 = acc[ai][bj][m][0], v1 = acc[ai][bj][m][1];
                float kv[8], kkv[8], kt[8], bb[8];
                unpack8(ksw[m], kv); unpack8(kkw[m], kkv);
#pragma unroll
                for (int j = 0; j < 4; ++j) { const float a_0 = sigm(v0[j] + b0[j]), a_1 = sigm(v1[j] + b1[j]);
                    kt[j] = kv[j] * (1.0f + (a_0 - 1.0f) * ka0[j]); kt[4 + j] = kv[4 + j] * (1.0f + (a_1 - 1.0f) * ka1[j]);
                    bb[j] = kkv[j] * a_0; bb[4 + j] = kkv[4 + j] * a_1; }
                *(u32x4*)(KT + ((size_t)d * NTOK + row) * 1024 + c) = pack8(kt); *(u32x4*)(BV + ((size_t)d * NTOK + row) * 1024 + c) = pack8(bb);
            EPI_ROWS_END } }
    }
};
struct EpiLoraG {
    bf16* GG;
    __device__ __forceinline__ void operator()(const f32x4 (&acc)[2][2][4][2], const Unit& u, int wr, int wc, int fr, int fq) const {
        const int cb = (u.pn & 3) * BM + wc * 32 + 8 * fq;
        EPI_ROWS_BEGIN
            const size_t row = (size_t)u.pm * BM + rl;
#pragma unroll
            for (int bj = 0; bj < 2; ++bj) { const int c = cb + bj * HALF; const f32x4 v0 = acc[ai][bj][m][0], v1 = acc[ai][bj][m][1];
                u32x4 w; w.x = cvt_pk_bf16_hz(v0[0], v0[1]); w.y = cvt_pk_bf16_hz(v0[2], v0[3]); w.z = cvt_pk_bf16_hz(v1[0], v1[1]); w.w = cvt_pk_bf16_hz(v1[2], v1[3]);
                *(u32x4*)(GG + row * 1024 + c) = w; }
        EPI_ROWS_END
    }
};
struct EpiMerge {
    bf16* M; const unsigned char* GT;
    __device__ __forceinline__ void operator()(const f32x4 (&acc)[2][2][4][2], const Unit& u, int wr, int wc, int fr, int fq) const {
        const int cb = u.pn * BM + wc * 32 + 8 * fq;
#pragma unroll
        for (int ai = 0; ai < 2; ++ai) {
        u32x2 gws[1][4][2]; u32x4 pws[1][4][2];
        EPI_HROWS_BEGIN
            const size_t row = (size_t)u.pm * BM + rl;
#pragma unroll
            for (int bj = 0; bj < 2; ++bj) { const int c = cb + bj * HALF; gws[0][m][bj] = *(const u32x2*)(GT + row * GLD + u.s * 2048 + c);
                pws[0][m][bj] = u.s ? *(const u32x4*)(M + row * 2048 + c) : (u32x4){0u, 0u, 0u, 0u}; }
        EPI_ROWS_END
        EPI_HROWS_BEGIN
            const size_t row = (size_t)u.pm * BM + rl;
#pragma unroll
            for (int bj = 0; bj < 2; ++bj) { const int c = cb + bj * HALF; const f32x4 v0 = acc[ai][bj][m][0], v1 = acc[ai][bj][m][1];
                const u32x2 gw = gws[0][m][bj]; constexpr float q = 1.0f / 255.0f;
                float o[8] = {v0[0] * ((float)(gw.x & 0xffu) * q), v0[1] * ((float)((gw.x >> 8) & 0xffu) * q), v0[2] * ((float)((gw.x >> 16) & 0xffu) * q), v0[3] * ((float)(gw.x >> 24) * q),
                              v1[0] * ((float)(gw.y & 0xffu) * q), v1[1] * ((float)((gw.y >> 8) & 0xffu) * q), v1[2] * ((float)((gw.y >> 16) & 0xffu) * q), v1[3] * ((float)(gw.y >> 24) * q)};
                bf16* dst = M + row * 2048 + c;
                { const u32x4 pw = pws[0][m][bj];
                    o[0] += bflo(pw.x); o[1] += bfhi(pw.x); o[2] += bflo(pw.y); o[3] += bfhi(pw.y); o[4] += bflo(pw.z); o[5] += bfhi(pw.z); o[6] += bflo(pw.w); o[7] += bfhi(pw.w); }
                u32x4 w; w.x = cvt_pk_bf16(o[0], o[1]); w.y = cvt_pk_bf16(o[2], o[3]); w.z = cvt_pk_bf16(o[4], o[5]); w.w = cvt_pk_bf16(o[6], o[7]);
                *(u32x4*)dst = w; }
        EPI_ROWS_END
        }
    }
};
struct EpiResF32 {
    bf16* O; const float* R;
    __device__ __forceinline__ void operator()(const f32x4 (&acc)[2][2][4][2], const Unit& u, int wr, int wc, int fr, int fq) const {
        const int cb = u.pn * BM + wc * 32 + 8 * fq;
#pragma unroll
        for (int ai = 0; ai < 2; ++ai) {
#pragma unroll
          for (int bj = 0; bj < 2; ++bj) {
            f32x4 xr[4][2][2];
#pragma unroll
            for (int m = 0; m < 4; ++m)
                { const size_t o = ((size_t)u.pm * BM + ai * HALF + wr * 64 + m * 16 + fr) * 2048 + cb + bj * HALF; xr[m][bj][0] = *(const f32x4*)(R + o); xr[m][bj][1] = *(const f32x4*)(R + o + 4); }
#pragma unroll
            for (int m = 0; m < 4; ++m)
                { const size_t o = ((size_t)u.pm * BM + ai * HALF + wr * 64 + m * 16 + fr) * 2048 + cb + bj * HALF;
                    const f32x4 h0 = xr[m][bj][0] + acc[ai][bj][m][0], h1 = xr[m][bj][1] + acc[ai][bj][m][1];
                    u32x4 w; w.x = cvt_pk_bf16_hz(h0[0], h0[1]); w.y = cvt_pk_bf16_hz(h0[2], h0[3]); w.z = cvt_pk_bf16_hz(h1[0], h1[1]); w.w = cvt_pk_bf16_hz(h1[2], h1[3]);
                    *(u32x4*)(O + o) = w; }
          }
        }
    }
};
struct EpiUp {
    unsigned char* H;
    __device__ __forceinline__ void operator()(const f32x4 (&acc)[2][2][4][2], const Unit& u, int wr, int wc, int fr, int fq) const {
        const int c = u.pn * HALF + wc * 32 + 8 * fq;
        EPI_ROWS_BEGIN
            const size_t row = (size_t)u.s + rl; float o[8];
#pragma unroll
            for (int n = 0; n < 2; ++n)
#pragma unroll
                for (int j = 0; j < 4; ++j) { const float g = acc[ai][0][m][n][j]; o[4 * n + j] = g * sigm(g) * acc[ai][1][m][n][j]; }
            u32x2 w; w.x = pk4_fp8(o[0], o[1], o[2], o[3]); w.y = pk4_fp8(o[4], o[5], o[6], o[7]);
            *(u32x2*)(H + row * EFF + c) = w;
        EPI_ROWS_END
    }
};
struct EpiDown {
    unsigned char* Y; const int* slot_dst; const float* slot_g;
    __device__ __forceinline__ void operator()(const f32x4 (&acc)[2][2][4][2], const Unit& u, int wr, int wc, int fr, int fq) const {
        const int cb = u.pn * BM + wc * 32 + 8 * fq;
        int dsts[2][4]; float gsc[2][4];
        EPI_ROWS_BEGIN
            dsts[ai][m] = slot_dst[u.s + rl]; gsc[ai][m] = slot_g[u.s + rl];
        EPI_ROWS_END
        EPI_ROWS_BEGIN
            const int dst = dsts[ai][m]; const float g = gsc[ai][m] * 16.0f; (void)rl;
            if (dst >= 0) {
#pragma unroll
                for (int bj = 0; bj < 2; ++bj) { const f32x4 v0 = acc[ai][bj][m][0] * g, v1 = acc[ai][bj][m][1] * g;
                    u32x2 w; w.x = pk4_fp8(v0[0], v0[1], v0[2], v0[3]); w.y = pk4_fp8(v1[0], v1[1], v1[2], v1[3]);
                    *(u32x2*)(Y + (size_t)dst * 2048 + cb + bj * HALF) = w; } }
        EPI_ROWS_END
    }
};
struct EpiP {
    unsigned char* P;
    __device__ __forceinline__ void operator()(const f32x4 (&acc)[2][2][4][2], const Unit& u, int wr, int wc, int fr, int fq) const {
        const int cb = u.pn * BM + wc * 32 + 8 * fq;
        EPI_ROWS_BEGIN
            const size_t row = (size_t)u.pm * BM + rl;
#pragma unroll
            for (int bj = 0; bj < 2; ++bj) { const size_t o = row * 2048 + cb + bj * HALF; const f32x4 v0 = acc[ai][bj][m][0], v1 = acc[ai][bj][m][1];
                u32x2 w; w.x = pk4_fp8(v0[0], v0[1], v0[2], v0[3]); w.y = pk4_fp8(v1[0], v1[1], v1[2], v1[3]); *(u32x2*)(P + o) = w; }
        EPI_ROWS_END
    }
};
struct EpiPleG {
    const unsigned char* P; bf16* O;
    __device__ __forceinline__ void operator()(const f32x4 (&acc)[2][2][4][2], const Unit& u, int wr, int wc, int fr0, int fq) const {
        int fr = fr0; asm volatile("" : "+v"(fr));
        const int cb = u.pn * BM + wc * 32 + 8 * fq;
#pragma unroll
        for (int ai = 0; ai < 2; ++ai)
#pragma unroll
          for (int bj = 0; bj < 2; ++bj) {
            u32x2 pws[4]; u32x4 hws[4];
            EPI_HROWS_BEGIN
                const size_t o = ((size_t)u.pm * BM + rl) * 2048 + cb + bj * HALF; pws[m] = *(const u32x2*)(P + o); hws[m] = *(const u32x4*)(O + o);
            EPI_ROWS_END
            EPI_HROWS_BEGIN
                const size_t o = ((size_t)u.pm * BM + rl) * 2048 + cb + bj * HALF; const f32x4 v0 = acc[ai][bj][m][0], v1 = acc[ai][bj][m][1];
                const u32x2 pw = pws[m]; const u32x4 hw = hws[m]; f32x4 h0 = {bflo(hw.x), bfhi(hw.x), bflo(hw.y), bfhi(hw.y)}, h1 = {bflo(hw.z), bfhi(hw.z), bflo(hw.w), bfhi(hw.w)};
                const f32x2 p0 = __builtin_amdgcn_cvt_pk_f32_fp8((int)pw.x, false), p1 = __builtin_amdgcn_cvt_pk_f32_fp8((int)pw.x, true), p2 = __builtin_amdgcn_cvt_pk_f32_fp8((int)pw.y, false), p3 = __builtin_amdgcn_cvt_pk_f32_fp8((int)pw.y, true);
                h0[0] += sigm(v0[0]) * p0.x; h0[1] += sigm(v0[1]) * p0.y; h0[2] += sigm(v0[2]) * p1.x; h0[3] += sigm(v0[3]) * p1.y;
                h1[0] += sigm(v1[0]) * p2.x; h1[1] += sigm(v1[1]) * p2.y; h1[2] += sigm(v1[2]) * p3.x; h1[3] += sigm(v1[3]) * p3.y;
                u32x4 w; w.x = cvt_pk_bf16_hz(h0[0], h0[1]); w.y = cvt_pk_bf16_hz(h0[2], h0[3]); w.z = cvt_pk_bf16_hz(h1[0], h1[1]); w.w = cvt_pk_bf16_hz(h1[2], h1[3]);
                *(u32x4*)(O + o) = w;
            EPI_ROWS_END
          }
    }
};
}

struct Frame {
    LAS unsigned char* lds; unsigned char* ws; const float* const* in; float* out;
    int tid, lane, wave, vcu, G, gw, NGW;
};
struct Args { const float* in[38]; float* out; unsigned char* ws; int ph_lo, ph_hi; };

__device__ __forceinline__ void tr_item(const float* W, int ldw, int k0, int n0, bf16* WT, size_t rowbase, int ldt, int kc0, LAS float* scr, int lane) {
    float v[32];
#pragma unroll
    for (int i = 0; i < 32; ++i) v[i] = W[(size_t)(k0 + 2 * i + (lane >> 5)) * ldw + n0 + (lane & 31)];
#pragma unroll
    for (int i = 0; i < 32; ++i) scr[(2 * i + (lane >> 5)) * 33 + (lane & 31)] = v[i];
    LDS_WAIT(); asm volatile("" ::: "memory");
    const int c = lane & 7;
#pragma unroll
    for (int j = 0; j < 4; ++j) { const int n = (lane >> 3) + 8 * j; const LAS float* s = scr + (8 * c) * 33 + n;
        u32x4 o; o.x = cvt_pk_bf16(s[0 * 33], s[1 * 33]); o.y = cvt_pk_bf16(s[2 * 33], s[3 * 33]); o.z = cvt_pk_bf16(s[4 * 33], s[5 * 33]); o.w = cvt_pk_bf16(s[6 * 33], s[7 * 33]);
        *(u32x4*)(WT + (rowbase + n) * ldt + kc0 + 8 * c) = o; }
    LDS_WAIT(); asm volatile("" ::: "memory");
}
__device__ __forceinline__ void tr_mat(const float* W, int K, int N, bf16* WT, size_t rowoff, int ldt, int kc0, int it, LAS float* scr, int lane) {
    const int nblk = N / 32, kb = it / nblk, nb = it % nblk;
    tr_item(W, N, 64 * kb, 32 * nb, WT, rowoff + 32 * nb, ldt, kc0 + 64 * kb, scr, lane);
}

__device__ __forceinline__ void tr_item8(const float* W, int ldw, int k0, int n0, unsigned char* WT, size_t rowbase, int ldt, int kc0, float scale, LAS float* scr, int lane) {
    float v[32];
#pragma unroll
    for (int i = 0; i < 32; ++i) v[i] = W[(size_t)(k0 + 2 * i + (lane >> 5)) * ldw + n0 + (lane & 31)];
#pragma unroll
    for (int i = 0; i < 32; ++i) scr[(2 * i + (lane >> 5)) * 33 + (lane & 31)] = v[i] * scale;
    LDS_WAIT(); asm volatile("" ::: "memory");
    const int c = lane & 3;
#pragma unroll
    for (int j = 0; j < 2; ++j) { const int n = (lane >> 2) + 16 * j; const LAS float* s = scr + (16 * c) * 33 + n;
        u32x4 o; o.x = pk4_fp8(s[0 * 33], s[1 * 33], s[2 * 33], s[3 * 33]); o.y = pk4_fp8(s[4 * 33], s[5 * 33], s[6 * 33], s[7 * 33]);
        o.z = pk4_fp8(s[8 * 33], s[9 * 33], s[10 * 33], s[11 * 33]); o.w = pk4_fp8(s[12 * 33], s[13 * 33], s[14 * 33], s[15 * 33]);
        *(u32x4*)(WT + (rowbase + n) * ldt + kc0 + 16 * c) = o; }
    LDS_WAIT(); asm volatile("" ::: "memory");
}
struct ConvItem { const float* src; unsigned char* dst; int ldw, ldt; float scale; };
__device__ __forceinline__ ConvItem conv_item(const float* const* in, unsigned char* ws, int it, int lane) {
    ConvItem c; const int e = it / 1536, r2 = it % 1536, which = r2 >> 9, q = r2 & 511;
    if (which < 2) { const float* src = e < 64 ? in[28 + which] + (size_t)e * 2048 * 512 : in[31 + which];
        const int kb = q >> 4, nb = q & 15, n0 = 32 * nb;
        c.src = src + (size_t)(64 * kb) * 512 + n0; c.ldw = 512; c.dst = ws + WS_WUP + ((size_t)e * 1024 + (n0 >> 7) * 256 + which * 128 + (n0 & 127)) * 2048 + 64 * kb; c.ldt = 2048; c.scale = 64.0f; }
    else { const float* src = e < 64 ? in[30] + (size_t)e * 512 * 2048 : in[33];
        const int kb = q >> 6, nb = q & 63;
        c.src = src + (size_t)(64 * kb) * 2048 + 32 * nb; c.ldw = 2048; c.dst = ws + WS_WDN + ((size_t)e * 2048 + 32 * nb) * 512 + 64 * kb; c.ldt = 512; c.scale = 32.0f; }
    return c;
}
__device__ __forceinline__ void conv_load(const ConvItem& c, float (&v)[32], int lane) {
#pragma unroll
    for (int i = 0; i < 32; ++i) v[i] = c.src[(size_t)(2 * i + (lane >> 5)) * c.ldw + (lane & 31)];
}
__device__ __forceinline__ void conv_store(const ConvItem& c, const float (&v)[32], LAS float* scr, int lane) {
#pragma unroll
    for (int i = 0; i < 32; ++i) scr[(2 * i + (lane >> 5)) * 33 + (lane & 31)] = v[i] * c.scale;
    LDS_WAIT(); asm volatile("" ::: "memory");
    const int cc = lane & 3;
#pragma unroll
    for (int j = 0; j < 2; ++j) { const int n = (lane >> 2) + 16 * j; const LAS float* s = scr + (16 * cc) * 33 + n;
        u32x4 o; o.x = pk4_fp8(s[0 * 33], s[1 * 33], s[2 * 33], s[3 * 33]); o.y = pk4_fp8(s[4 * 33], s[5 * 33], s[6 * 33], s[7 * 33]);
        o.z = pk4_fp8(s[8 * 33], s[9 * 33], s[10 * 33], s[11 * 33]); o.w = pk4_fp8(s[12 * 33], s[13 * 33], s[14 * 33], s[15 * 33]);
        *(u32x4*)(c.dst + (size_t)n * c.ldt + 16 * cc) = o; }
    LDS_WAIT(); asm volatile("" ::: "memory");
}
__device__ __forceinline__ void expert_conv_pair(const float* const* in, unsigned char* ws, int it0, int it1, LAS float* scr, int lane) {
    constexpr int NIT = 65 * 1536;
    if (it0 >= NIT) return;
    const ConvItem c0 = conv_item(in, ws, it0, lane); float v0[32]; conv_load(c0, v0, lane);
    if (it1 < NIT) { const ConvItem c1 = conv_item(in, ws, it1, lane); float v1[32]; conv_load(c1, v1, lane); conv_store(c0, v0, scr, lane); conv_store(c1, v1, scr, lane); }
    else conv_store(c0, v0, scr, lane);
}
struct ConvQ { const float* src; unsigned char* dst; int ldw, ldt; float scale; };
__device__ __forceinline__ ConvQ conv_quad_item(const float* const* in, unsigned char* ws, int it, int lane) {
    ConvQ c; const int e = it / 768, r2 = it % 768, which = r2 >> 8, q = r2 & 255, r = lane >> 5, cc = lane & 31;
    if (which < 2) { const float* W = e < 64 ? in[28 + which] + (size_t)e * 2048 * 512 : in[31 + which];
        const int kb = q >> 2, nb = q & 3; c.ldw = 512; c.ldt = 2048; c.scale = 64.0f;
        c.src = W + (size_t)(32 * kb + 16 * r) * 512 + 128 * nb + 4 * cc;
        c.dst = ws + WS_WUP + ((size_t)e * 1024 + nb * 256 + which * 128 + 4 * cc) * 2048 + 32 * kb + 16 * r; }
    else { const float* W = e < 64 ? in[30] + (size_t)e * 512 * 2048 : in[33];
        const int kb = q >> 4, nb = q & 15; c.ldw = 2048; c.ldt = 512; c.scale = 32.0f;
        c.src = W + (size_t)(32 * kb + 16 * r) * 2048 + 128 * nb + 4 * cc;
        c.dst = ws + WS_WDN + ((size_t)e * 2048 + 128 * nb + 4 * cc) * 512 + 32 * kb + 16 * r; }
    return c;
}
__device__ __forceinline__ void conv_quad_load(const ConvQ& c, f32x4 (&v)[16]) {
#pragma unroll
    for (int i = 0; i < 16; ++i) v[i] = *(const f32x4*)(c.src + (size_t)i * c.ldw);
}
__device__ __forceinline__ void conv_quad_store(const ConvQ& c, const f32x4 (&v)[16]) {
#pragma unroll
    for (int e4 = 0; e4 < 4; ++e4) { unsigned w[4];
#pragma unroll
        for (int g = 0; g < 4; ++g) w[g] = pk4_fp8(v[4 * g][e4] * c.scale, v[4 * g + 1][e4] * c.scale, v[4 * g + 2][e4] * c.scale, v[4 * g + 3][e4] * c.scale);
        *(u32x4*)(c.dst + (size_t)e4 * c.ldt) = (u32x4){w[0], w[1], w[2], w[3]}; }
}
__device__ __forceinline__ void rms_row_bf16(const float* xrow, const f32x4 (&gg8)[8], bf16* orow, unsigned char* orow8, int lane) {
    const f32x4* xr = (const f32x4*)xrow + lane;
    f32x4 v[8]; float s = 0.f;
#pragma unroll
    for (int j = 0; j < 8; ++j) { v[j] = xr[64 * j]; s += (v[j].x * v[j].x + v[j].y * v[j].y) + (v[j].z * v[j].z + v[j].w * v[j].w); }
    const float rstd = __builtin_amdgcn_rsqf(wave_sum(s) * (1.f / DM) + RMS_EPS);
    u32x2* o8 = (u32x2*)orow + lane; unsigned* o4 = (unsigned*)orow8 + lane;
#pragma unroll
    for (int j = 0; j < 8; ++j) { const f32x4 gg = gg8[j]; const float a = v[j].x * rstd * gg.x, b = v[j].y * rstd * gg.y, c = v[j].z * rstd * gg.z, d = v[j].w * rstd * gg.w;
        u32x2 w; w.x = cvt_pk_bf16(a, b); w.y = cvt_pk_bf16(c, d); o8[64 * j] = w; o4[64 * j] = pk4_fp8(a, b, c, d); }
}

__device__ __forceinline__ void p0_prologue(Frame& F) {
    LAS float* scr = (LAS float*)(F.lds + F.wave * 16384);
    unsigned char* ws = F.ws;
    bf16* W1 = (bf16*)(ws + WS_W1); bf16* WBR = (bf16*)(ws + WS_WBR); bf16* WOUT = (bf16*)(ws + WS_WOUT); bf16* WPG = (bf16*)(ws + WS_WPG); bf16* WPP = (bf16*)(ws + WS_WPP); bf16* WL = (bf16*)(ws + WS_WL);
    constexpr int I_IN = 32 * 205, I_BG = 32 * 128, I_BR = 16 * 64, I_O = 32 * 64, I_PP = 4 * 64, I_LO = 32;
    constexpr int NIT = I_IN + I_BG + 2 * I_BR + 2 * I_O + I_PP + 4 * I_LO;
    for (int it = F.gw; it < NIT; it += F.NGW) {
        int r = it;
        if (r < I_IN) { tr_mat(F.in[3], 2048, 6560, W1, 0, 2048, 0, r, scr, F.lane); continue; } r -= I_IN;
        if (r < I_BG) { const int kb = r >> 7, nb = r & 127; tr_item8(F.in[4], 4096, 64 * kb, 32 * nb, ws + WS_W1G8, (size_t)32 * nb, 2048, 64 * kb, 64.0f, scr, F.lane); continue; } r -= I_BG;
        if (r < I_BR) { tr_mat(F.in[22], 1024, 2048, WBR, 0, 1024, 0, r, scr, F.lane); continue; } r -= I_BR;
        if (r < I_BR) { tr_mat(F.in[23], 1024, 2048, WBR, 2048, 1024, 0, r, scr, F.lane); continue; } r -= I_BR;
        if (r < I_O) { tr_mat(F.in[24], 2048, 2048, WOUT, 0, 2048, 0, r, scr, F.lane); continue; } r -= I_O;
        if (r < I_O) { const int kb = r >> 6, nb = r & 63; tr_item8(F.in[35], 2048, 64 * kb, 32 * nb, (unsigned char*)WPG, (size_t)32 * nb, 2048, 64 * kb, 64.0f, scr, F.lane); continue; } r -= I_O;
        if (r < I_PP) { tr_mat(F.in[36], 256, 2048, WPP, 0, 2048, 0, r, scr, F.lane); continue; } r -= I_PP;
        { const int which = r / I_LO, nb = r % I_LO, d = which & 1;
          const float* src = (which < 2 ? F.in[13] : F.in[15]) + (size_t)d * 64 * 1024;
          tr_item(src, 1024, 0, 32 * nb, WL, (size_t)(which < 2 ? 0 : 2048) + d * 1024 + 32 * nb, 256, (which < 2 ? 0 : 128) + d * 64, scr, F.lane); }
    }
    const int gt = F.gw * 64 + F.lane, NGT = F.NGW * 64;
    for (int i = gt; i < 160 * 1024; i += NGT) { const int k = i >> 10, n = i & 1023; WL[(size_t)(4096 + n) * 256 + k] = (bf16)(cvt_pk_bf16(F.in[16][i], 0.f) & 0xffffu); }
    for (int i = gt; i < 5120 * 32; i += NGT) { const int row = i >> 5, k8 = (i & 31) * 8;
        const int k0 = row < 2048 ? (row >> 10) * 64 : row < 4096 ? 128 + ((row - 2048) >> 10) * 64 : 0, kl = row < 4096 ? 64 : 160;
        if (k8 < k0 || k8 >= k0 + kl) *(u32x4*)(WL + (size_t)row * 256 + k8) = (u32x4){0u, 0u, 0u, 0u}; }
    for (int i = gt; i < 96 * 256; i += NGT) *(u32x4*)(W1 + (size_t)6560 * 2048 + (size_t)i * 8) = (u32x4){0u, 0u, 0u, 0u};
    { bf16* WF = (bf16*)(ws + WS_WRT); const float* g = F.in[25]; const float* wr = F.in[26];
      for (int i = gt; i < 2048 * 64; i += NGT) { const int k = i >> 6, e = i & 63; const float v = g[k] * wr[i]; const unsigned hb = cvt_pk_bf16(v, 0.f) & 0xffffu; const float vh = __builtin_bit_cast(float, hb << 16);
          const size_t o = ((size_t)((k >> 4) * 4 + (e >> 5) * 2) * 64 + ((k >> 3) & 1) * 32 + (e & 31)) * 8 + (k & 7);
          WF[o] = (bf16)hb; WF[o + 512] = (bf16)(cvt_pk_bf16(v - vh, 0.f) & 0xffffu); } }
    { u32x2* PB = (u32x2*)(ws + WS_PB); const f32x4* p = (const f32x4*)F.in[1];
      for (int i = gt; i < NTOK * 256 / 4; i += NGT) { const f32x4 v = p[i]; u32x2 w; w.x = cvt_pk_bf16(v.x, v.y); w.y = cvt_pk_bf16(v.z, v.w); PB[i] = w; } }
    bf16* U = (bf16*)(ws + WS_U);
    f32x4 gg8[8];
#pragma unroll
    for (int j = 0; j < 8; ++j) gg8[j] = ((const f32x4*)F.in[2] + F.lane)[64 * j];
    for (int m = F.gw; m < NTOK; m += F.NGW) rms_row_bf16(F.in[0] + (size_t)m * DM, gg8, U + (size_t)m * DM, ws + WS_U8E + (size_t)m * DM, F.lane);
}

__device__ __forceinline__ void shift16(const bf16* zr, bool hasp, bool hasn, int c0, const float* mp, const float* mn, float (&o)[16]) {
#pragma unroll
    for (int hh = 0; hh < 2; ++hh) {
        float z[8], zp[8], zn[8];
        unpack8(*(const u32x4*)(zr + c0 + 8 * hh), z);
        if (hasp) unpack8(*(const u32x4*)(zr - ZLD + c0 + 8 * hh), zp);
        if (hasn) unpack8(*(const u32x4*)(zr + ZLD + c0 + 8 * hh), zn);
#pragma unroll
        for (int j = 0; j < 8; ++j) { const float p = hasp ? zp[j] : 0.f, n = hasn ? zn[j] : 0.f; o[8 * hh + j] = z[j] + mp[c0 + 8 * hh + j] * (p - z[j]) + mn[c0 + 8 * hh + j] * (n - z[j]); }
    }
}
struct ShRaw { u32x4 z[2], zp[2], zn[2]; };
__device__ __forceinline__ void shift_load(const bf16* zr, bool hasp, bool hasn, int c0, ShRaw& w) {
#pragma unroll
    for (int hh = 0; hh < 2; ++hh) { w.z[hh] = *(const u32x4*)(zr + c0 + 8 * hh);
        w.zp[hh] = hasp ? *(const u32x4*)(zr - ZLD + c0 + 8 * hh) : (u32x4){0u, 0u, 0u, 0u}; w.zn[hh] = hasn ? *(const u32x4*)(zr + ZLD + c0 + 8 * hh) : (u32x4){0u, 0u, 0u, 0u}; }
}
__device__ __forceinline__ void shift_comp(const ShRaw& w, int c0, const LAS float* mp, const LAS float* mn, float (&o)[16]) {
#pragma unroll
    for (int hh = 0; hh < 2; ++hh) { float z[8], zp[8], zn[8]; unpack8(w.z[hh], z); unpack8(w.zp[hh], zp); unpack8(w.zn[hh], zn);
        const f32x4 p0 = *(const LAS f32x4*)(mp + c0 + 8 * hh), p1 = *(const LAS f32x4*)(mp + c0 + 8 * hh + 4), n0 = *(const LAS f32x4*)(mn + c0 + 8 * hh), n1 = *(const LAS f32x4*)(mn + c0 + 8 * hh + 4);
#pragma unroll
        for (int j = 0; j < 4; ++j) { o[8 * hh + j] = z[j] + p0[j] * (zp[j] - z[j]) + n0[j] * (zn[j] - z[j]); o[8 * hh + 4 + j] = z[4 + j] + p1[j] * (zp[4 + j] - z[4 + j]) + n1[j] * (zn[4 + j] - z[4 + j]); } }
}
__device__ __forceinline__ void store16(bf16* dst, const float (&o)[16]) {
    float a[8], b[8];
#pragma unroll
    for (int j = 0; j < 8; ++j) { a[j] = o[j]; b[j] = o[8 + j]; }
    *(u32x4*)dst = pack8(a); *(u32x4*)(dst + 8) = pack8(b);
}
__device__ __forceinline__ void p2_shift(Frame& F) {
    unsigned char* ws = F.ws;
    const bf16* Z = (const bf16*)(ws + WS_Z); bf16* R = (bf16*)(ws + WS_R); bf16* KS = (bf16*)(ws + WS_KS); bf16* V = (bf16*)(ws + WS_V); bf16* KK = (bf16*)(ws + WS_KK); bf16* AP = (bf16*)(ws + WS_AP);
    const int lane = F.lane;
    LAS float* mp = (LAS float*)F.lds; LAS float* mn = mp + 3584; LAS float* k_k = mn + 3584;
    for (int i = F.tid; i < 3488; i += 512) { mp[i] = F.in[10][i]; mn[i] = F.in[11][i]; }
    for (int i = F.tid; i < 1024; i += 512) k_k[i] = F.in[17][i];
    __syncthreads();
    for (int t = F.gw; t < NTOK; t += F.NGW) {
        const int tt = t & (SEQ - 1); const bool hasp = tt != 0, hasn = tt != SEQ - 1;
        const bf16* zr = Z + (size_t)t * ZLD + ZR;
        ShRaw wR, wV, wK, wL; float o[16], oL[16];
        shift_load(zr, hasp, hasn, 16 * lane, wR); shift_load(zr, hasp, hasn, 2048 + 16 * lane, wV); shift_load(zr, hasp, hasn, 1024 + 16 * lane, wK);
        if (lane < 26) shift_load(zr, hasp, hasn, 3072 + 16 * lane, wL);
        shift_comp(wR, 16 * lane, mp, mn, o); store16(R + (size_t)t * 1024 + 16 * lane, o);
        shift_comp(wV, 2048 + 16 * lane, mp, mn, o); store16(V + (size_t)t * 1024 + 16 * lane, o);
        if (lane < 26) shift_comp(wL, 3072 + 16 * lane, mp, mn, oL);
        shift_comp(wK, 1024 + 16 * lane, mp, mn, o); store16(KS + (size_t)t * 1024 + 16 * lane, o);
        float ss = 0.f;
#pragma unroll
        for (int j = 0; j < 16; ++j) { o[j] *= k_k[16 * lane + j]; ss += o[j] * o[j]; }
        ss = quad_sum(ss);
        const float rn = __builtin_amdgcn_rsqf(fmaxf(ss, 1e-12f));
#pragma unroll
        for (int j = 0; j < 16; ++j) o[j] *= rn;
        store16(KK + (size_t)t * 1024 + 16 * lane, o);
        if (lane < 32) {
            if (lane < 26) {
                if (lane < 8) {
#pragma unroll
                    for (int j = 0; j < 16; ++j) { const float e = ex2(2.0f * LOG2E * oL[j]); oL[j] = 1.0f - 2.0f * __builtin_amdgcn_rcpf(e + 1.0f); }
                } else if (lane >= 16) {
#pragma unroll
                    for (int j = 0; j < 16; ++j) oL[j] = sigm(oL[j]);
                } }
            else {
#pragma unroll
                for (int j = 0; j < 16; ++j) oL[j] = 0.f; }
            store16(AP + (size_t)t * 512 + 16 * lane, oL);
        }
    }
    __syncthreads();
    bf16* VT = (bf16*)(ws + WS_VT);
    LAS bf16* scr = (LAS bf16*)(F.lds + F.wave * 16640);
    for (int it = F.gw; it < NB * 8 * 32; it += F.NGW) {
        const int tb = it & 31, bh = it >> 5, b = bh >> 3, h = bh & 7;
        const bf16* src = Z + (size_t)(b * SEQ + tb * 64) * ZLD + 2048 + h * 128 + 2 * lane;
#pragma unroll 8
        for (int r = 0; r < 64; ++r) *(LAS unsigned*)(scr + r * 130 + 2 * lane) = *(const unsigned*)(src + (size_t)r * ZLD);
        LDS_WAIT(); asm volatile("" ::: "memory");
        const int dvr = lane >> 3, c = lane & 7;
#pragma unroll 4
        for (int i = 0; i < 16; ++i) { const int dv = 8 * i + dvr; const LAS bf16* s = scr + (8 * c) * 130 + dv;
            u32x4 w; w.x = (unsigned)s[0] | ((unsigned)s[130] << 16); w.y = (unsigned)s[260] | ((unsigned)s[390] << 16); w.z = (unsigned)s[520] | ((unsigned)s[650] << 16); w.w = (unsigned)s[780] | ((unsigned)s[910] << 16);
            *(u32x4*)(VT + ((size_t)bh * 128 + dv) * SEQ + tb * 64 + 8 * c) = w; }
        LDS_WAIT(); asm volatile("" ::: "memory");
    }
}

constexpr int ATT_KP = 272, ATT_VP = 144, ATT_KB = 64 * ATT_KP, ATT_VB = 128 * ATT_VP, ATT_BUF = ATT_KB + ATT_VB;
__device__ __forceinline__ void attn_phase(Frame& F) {
    unsigned char* ws = F.ws;
    const bf16* Z = (const bf16*)(ws + WS_Z); const bf16* VT = (const bf16*)(ws + WS_VT); bf16* YA = (bf16*)(ws + WS_YA);
    const int tid = F.tid, lane = F.lane, wave = F.wave, qs = wave & 3, map = wave >> 2, c = lane & 31, hh = lane >> 5;
    float lam;
    { const float a = wave_sum(F.in[5][lane] * F.in[6][lane]), b2 = wave_sum(F.in[7][lane] * F.in[8][lane]); lam = ex2(a * LOG2E) - ex2(b2 * LOG2E) + 0.2f; }
    const float* subg = F.in[9];
    LAS unsigned char* lds = F.lds;
    if (wave >= 4) __builtin_amdgcn_s_setprio(1);
    for (int ui = 0; ui < 4; ++ui) {
        if (F.vcu >= 256) break;
        const int b = F.vcu >> 5, qb = (F.vcu >> 1) & 15, ty = F.vcu & 1;
        const int h = (ui == 0) ? ty : (ui == 1) ? 7 - ty : (ui == 2) ? 3 - ty : 4 + ty;
        const int bh = b * 8 + h;
        const int tok0 = b * SEQ, q0 = qb * 128 + qs * 32;
        const float slope2 = ex2(-(float)(h + 1)) * LOG2E;
        const float sc2 = 0.125f * LOG2E;
        bf16x8 qf[4];
        { const bf16* qp = Z + (size_t)(tok0 + q0 + c) * ZLD + h * 128 + map * 64 + 8 * hh;
#pragma unroll
          for (int s = 0; s < 4; ++s) qf[s] = *(const bf16x8*)(qp + 16 * s); }
        f32x16 O[4];
#pragma unroll
        for (int d = 0; d < 4; ++d)
#pragma unroll
            for (int j = 0; j < 16; ++j) O[d][j] = 0.f;
        float mrun = -1e30f, muse = -1e30f, lrun = 0.f;
        const float cc = ex2((float)(2 - h)); const int q0w = q0;
        unsigned qaug1 = 0u, kaug1[2] = {0u, 0u};
        if (hh == 0) { qaug1 = cvt_pk_bf16((float)c, 1.0f);
#pragma unroll
          for (int kb = 0; kb < 2; ++kb) kaug1[kb] = cvt_pk_bf16(-cc, cc * (float)(32 * kb + c)); }
        const int dtile = q0w >> 6;
        unsigned koff[2], voff[2]; int kdst[2], vdst[2];
        const char* Zb = (const char*)(Z + (size_t)tok0 * ZLD + 1024 + h * 128); const char* Vb = (const char*)(VT + (size_t)bh * 128 * SEQ);
#pragma unroll
        for (int i = 0; i < 2; ++i) { const int q = tid + 512 * i;
            koff[i] = (unsigned)((q >> 4) * ZLD + (q & 15) * 8) * 2u; kdst[i] = (q >> 4) * ATT_KP + (q & 15) * 16;
            voff[i] = (unsigned)((q >> 3) * SEQ + (q & 7) * 8) * 2u; vdst[i] = ATT_KB + (q >> 3) * ATT_VP + ((q & 7) >> 1) * 32 + (q & 1) * 8; }
        u32x4 kr[2], vr[2];
        int tlo, thi;
        { const unsigned* T = (const unsigned*)(ws + WS_CTL) + CW_QKN + b * 64 + h * 4;
          float bmax = 0.f;
#pragma unroll
          for (int mp = 0; mp < 2; ++mp) {
              const float q2 = __uint_as_float(__hip_atomic_load(T + mp * 2, __ATOMIC_RELAXED, __HIP_MEMORY_SCOPE_AGENT)) + __uint_as_float(__hip_atomic_load(T + mp * 2 + 1, __ATOMIC_RELAXED, __HIP_MEMORY_SCOPE_AGENT));
              const float k2 = __uint_as_float(__hip_atomic_load(T + 32 + mp * 2, __ATOMIC_RELAXED, __HIP_MEMORY_SCOPE_AGENT)) + __uint_as_float(__hip_atomic_load(T + 32 + mp * 2 + 1, __ATOMIC_RELAXED, __HIP_MEMORY_SCOPE_AGENT));
              bmax = fmaxf(bmax, q2 * k2); }
          const float Bb = __builtin_sqrtf(bmax) * sc2 * 1.02f;
          const float dk = fminf((30.0f + 2.0f * Bb) / slope2, 4096.0f);
          const int Di = __builtin_amdgcn_readfirstlane((int)dk + 1), q0b = qb * 128;
          const int a = q0b - 63 - Di; tlo = a <= 0 ? 0 : (a + 63) >> 6;
          const int e = (q0b + 127 + Di) >> 6; thi = e > 31 ? 31 : e; }
        const int nt = thi - tlo + 1;
        const int t0 = 2 * qb;
#pragma unroll
        for (int i = 0; i < 2; ++i) { kr[i] = *(const u32x4*)(Zb + (size_t)(t0 * 64) * ZLD * 2 + koff[i]); vr[i] = *(const u32x4*)(Vb + t0 * 64 * 2 + voff[i]); }
#pragma unroll
        for (int i = 0; i < 2; ++i) { *(LAS u32x4*)(lds + kdst[i]) = kr[i]; *(LAS u32x2*)(lds + vdst[i]) = (u32x2){vr[i].x, vr[i].y}; *(LAS u32x2*)(lds + vdst[i] + 16) = (u32x2){vr[i].z, vr[i].w}; }
        __syncthreads();
        for (int it = 0; it < nt; ++it) {
            int xt = t0 - tlo + it; if (xt >= nt) xt -= nt;
            const int tt = tlo + xt, j0 = tt * 64; LAS unsigned char* buf = lds + (it & 1) * ATT_BUF;
            if (it + 1 < nt) { int xn = xt + 1; if (xn >= nt) xn -= nt; const int jn = (tlo + xn) * 64;
#pragma unroll
                for (int i = 0; i < 2; ++i) { kr[i] = *(const u32x4*)(Zb + (size_t)jn * ZLD * 2 + koff[i]); vr[i] = *(const u32x4*)(Vb + jn * 2 + voff[i]); } }
            const bool diag = (tt == dtile), left = (j0 < q0w);
            f32x16 S[2];
            { bf16x8 kf[2][4];
#pragma unroll
              for (int kb = 0; kb < 2; ++kb)
#pragma unroll
                for (int s = 0; s < 4; ++s) kf[kb][s] = *(const LAS bf16x8*)(buf + (32 * kb + c) * ATT_KP + (map * 64 + 16 * s + 8 * hh) * 2);
              __builtin_amdgcn_sched_barrier(0);
#pragma unroll
              for (int kb = 0; kb < 2; ++kb) {
#pragma unroll
                for (int j = 0; j < 16; ++j) S[kb][j] = 0.f;
#pragma unroll
                for (int s = 0; s < 4; ++s) S[kb] = __builtin_amdgcn_mfma_f32_32x32x16_bf16(kf[kb][s], qf[s], S[kb], 0, 0, 0); } }
            float tb2;
            if (!diag) {
#pragma unroll
                for (int kb = 0; kb < 2; ++kb) { u32x4 k = {kaug1[kb], 0u, 0u, 0u}; if (!left) k.x ^= 0x80008000u; const u32x4 qa = {qaug1, 0u, 0u, 0u};
                    S[kb] = __builtin_amdgcn_mfma_f32_32x32x16_bf16(__builtin_bit_cast(bf16x8, k), __builtin_bit_cast(bf16x8, qa), S[kb], 0, 0, 0); }
                tb2 = -slope2 * (float)(left ? (q0w - j0) : (j0 - q0w));
            } else {
                int dd0 = q0w + c - j0 - 4 * hh; asm volatile("" : "+v"(dd0));
#pragma unroll
                for (int kb = 0; kb < 2; ++kb)
#pragma unroll
                    for (int r = 0; r < 16; ++r) { const int dd = dd0 - (32 * kb + (r & 3) + 8 * (r >> 2)); S[kb][r] -= cc * (float)(dd < 0 ? -dd : dd); }
                tb2 = 0.f;
            }
            float mx = -1e30f;
#pragma unroll
            for (int kb = 0; kb < 2; ++kb)
#pragma unroll
                for (int r = 0; r < 16; ++r) mx = fmaxf(mx, S[kb][r]);
            mx = mx * sc2 + tb2;
            mx = fmaxf(mx, __shfl_xor(mx, 32));
            const float mnew = fmaxf(mrun, mx);
            const bool skip = __all(mx < mrun - 30.0f);
            mrun = mnew;
            if (!skip) {
                if (__any(mnew > muse + 8.0f)) {
                    const float alpha = ex2(muse - mnew); muse = mnew; lrun *= alpha;
#pragma unroll
                    for (int d = 0; d < 4; ++d)
#pragma unroll
                        for (int j = 0; j < 16; ++j) O[d][j] *= alpha; }
                const float off = tb2 - muse;
                float ls = 0.f; bf16x8 pf[2][2];
#pragma unroll
                for (int kb = 0; kb < 2; ++kb)
#pragma unroll
                    for (int s = 0; s < 2; ++s) { float p[8];
#pragma unroll
                        for (int j = 0; j < 8; ++j) { p[j] = ex2(__builtin_fmaf(S[kb][8 * s + j], sc2, off)); ls += p[j]; }
                        const u32x4 w = pack8(p); pf[kb][s] = __builtin_bit_cast(bf16x8, w); }
                lrun += ls;
                __builtin_amdgcn_sched_barrier(0);
                u32x4 vw[8];
#define ATT_VLOAD(i_) { vw[(i_) & 7] = *(const LAS u32x4*)(buf + ATT_KB + (32 * ((i_) >> 2) + c) * ATT_VP + ((i_) & 3) * 32 + hh * 16); }
#pragma unroll
                for (int i = 0; i < 8; ++i) ATT_VLOAD(i)
                __builtin_amdgcn_sched_barrier(0);
#pragma unroll
                for (int i = 0; i < 16; ++i) {
                    O[i >> 2] = __builtin_amdgcn_mfma_f32_32x32x16_bf16(__builtin_bit_cast(bf16x8, vw[i & 7]), pf[(i >> 1) & 1][i & 1], O[i >> 2], 0, 0, 0);
                    if (i + 8 < 16) ATT_VLOAD(i + 8)
                    __builtin_amdgcn_sched_barrier(0);
                }
#undef ATT_VLOAD
            }
            if (it + 1 < nt) { LAS unsigned char* nb = lds + ((it + 1) & 1) * ATT_BUF;
#pragma unroll
                for (int i = 0; i < 2; ++i) { *(LAS u32x4*)(nb + kdst[i]) = kr[i]; *(LAS u32x2*)(nb + vdst[i]) = (u32x2){vr[i].x, vr[i].y}; *(LAS u32x2*)(nb + vdst[i] + 16) = (u32x2){vr[i].z, vr[i].w}; } }
            __syncthreads();
        }
        const float ltot = lrun + __shfl_xor(lrun, 32); const float inv = __builtin_amdgcn_rcpf(ltot);
        LAS float* X = (LAS float*)lds;
        int tl = tid; asm volatile("" : "+v"(tl));
        const int c = tl & 31, hh = (tl >> 5) & 1, qs = (tl >> 6) & 3;
        if (map == 1) {
#pragma unroll
            for (int d = 0; d < 4; ++d)
#pragma unroll
                for (int g = 0; g < 4; ++g) { f32x4 v;
#pragma unroll
                    for (int j = 0; j < 4; ++j) v[j] = O[d][4 * g + j] * (inv * lam);
                    *(LAS f32x4*)(X + (qs * 32 + c) * 132 + 32 * d + 8 * g + 4 * hh) = v; }
        }
        __syncthreads();
        if (map == 0) {
            float ss = 0.f;
#pragma unroll
            for (int d = 0; d < 4; ++d)
#pragma unroll
                for (int g = 0; g < 4; ++g) { const f32x4 x = *(const LAS f32x4*)(X + (qs * 32 + c) * 132 + 32 * d + 8 * g + 4 * hh);
#pragma unroll
                    for (int j = 0; j < 4; ++j) { const float o = O[d][4 * g + j] * inv - x[j]; O[d][4 * g + j] = o; ss += o * o; } }
            ss += __shfl_xor(ss, 32);
            const float rn = __builtin_amdgcn_rsqf(ss * (1.f / 128.f) + RMS_EPS) * 0.8f;
            bf16* yp = YA + (size_t)(tok0 + q0 + c) * 1024 + h * 128;
            f32x4 sgv[4][4];
#pragma unroll
            for (int d = 0; d < 4; ++d)
#pragma unroll
                for (int g = 0; g < 4; ++g) sgv[d][g] = *(const f32x4*)(subg + 32 * d + 8 * g + 4 * hh);
#pragma unroll
            for (int d = 0; d < 4; ++d)
#pragma unroll
                for (int g = 0; g < 4; ++g) { const int dv = 32 * d + 8 * g + 4 * hh; const f32x4 sg = sgv[d][g];
                    u32x2 w; w.x = cvt_pk_bf16(O[d][4 * g] * rn * sg[0], O[d][4 * g + 1] * rn * sg[1]); w.y = cvt_pk_bf16(O[d][4 * g + 2] * rn * sg[2], O[d][4 * g + 3] * rn * sg[3]);
                    *(u32x2*)(yp + dv) = w; }
        }
        __syncthreads();
    }
    __builtin_amdgcn_s_setprio(0);
}

constexpr int SCN_VEC = 0, SCN_WLO = 8192, SCN_WHI = SCN_WLO + 4352, SCN_KB = SCN_WHI + 4352, SCN_V = SCN_KB + 8704, SCN_SC = SCN_V + 8192, SCN_BUF = SCN_SC + 512;
constexpr int SCN_YST = 2 * SCN_BUF, SCN_END = SCN_YST + 2 * 8192;
static_assert(SCN_END <= LDSCTL_OFF, "scan LDS map");
struct ScanRegs { u32x2 r, kk, v, kt, bv, dd; };
template <bool CONV> __device__ __forceinline__ void scan_phase(Frame& F) {
    unsigned char* ws = F.ws;
    const int tid = F.tid, seq = F.vcu; if (seq >= 256) return;
    const int dir = seq >> 7, b = (seq >> 4) & 7, h = seq & 15;
    const bf16* R = (const bf16*)(ws + WS_R); const bf16* KK = (const bf16*)(ws + WS_KK); const bf16* V = (const bf16*)(ws + WS_V);
    const bf16* KT = (const bf16*)(ws + WS_KT) + (size_t)dir * NTOK * 1024; const bf16* BV = (const bf16*)(ws + WS_BV) + (size_t)dir * NTOK * 1024;
    const bf16* DD = (const bf16*)(ws + WS_WD) + (size_t)dir * NTOK * 1024; bf16* YS = (bf16*)(ws + WS_YS) + (size_t)dir * NTOK * 1024;
    LAS unsigned char* L = F.lds;
    for (int k = tid; k < 2 * 16 * 16; k += 512) { const int bi = k >> 8, r2 = k & 255, st = r2 >> 4, w = r2 & 15;
        const int off = (w < 4) ? SCN_WLO + st * 272 + 256 + 4 * w : (w < 8) ? SCN_WHI + st * 272 + 256 + 4 * (w - 4) : SCN_KB + st * 544 + 512 + 4 * (w - 8);
        *(LAS unsigned*)(L + bi * SCN_BUF + off) = 0u; }
    const int t4 = tid & 255, part = t4 & 15, lsA = t4 >> 4, lsB = lsA + 16;
    auto gload = [&](ScanRegs& g, int cchunk, int ls) { const int tt = cchunk * 32 + ls; const int t = dir ? (SEQ - 1 - tt) : tt; const size_t o = (size_t)(b * SEQ + t) * 1024 + h * 64 + 4 * part;
        g.r = *(const u32x2*)(R + o); g.kk = *(const u32x2*)(KK + o); g.v = *(const u32x2*)(V + o); g.kt = *(const u32x2*)(KT + o); g.bv = *(const u32x2*)(BV + o); g.dd = *(const u32x2*)(DD + o); };
    auto lstore = [&](const ScanRegs& g, int bi, int ls) { LAS unsigned char* B = L + bi * SCN_BUF; const int pr = ls >> 1; const bool odd = ls & 1;
        const f32x4 lw = 1.0f - (f32x4){bflo(g.dd.x), bfhi(g.dd.x), bflo(g.dd.y), bfhi(g.dd.y)};
        const f32x4 r = {bflo(g.r.x), bfhi(g.r.x), bflo(g.r.y), bfhi(g.r.y)}, kk = {bflo(g.kk.x), bfhi(g.kk.x), bflo(g.kk.y), bfhi(g.kk.y)}, v = {bflo(g.v.x), bfhi(g.v.x), bflo(g.v.y), bfhi(g.v.y)};
        const f32x4 kt = {bflo(g.kt.x), bfhi(g.kt.x), bflo(g.kt.y), bfhi(g.kt.y)}, bb = {bflo(g.bv.x), bfhi(g.bv.x), bflo(g.bv.y), bfhi(g.bv.y)};
        f32x4 wp; wp.x = __shfl_xor(lw.x, 16); wp.y = __shfl_xor(lw.y, 16); wp.z = __shfl_xor(lw.z, 16); wp.w = __shfl_xor(lw.w, 16);
        const unsigned pk0 = __shfl_xor(g.kk.x, 16), pk1 = __shfl_xor(g.kk.y, 16), pr0 = __shfl_xor(g.r.x, 16), pr1 = __shfl_xor(g.r.y, 16);
        const f32x4 kkp = {bflo(pk0), bfhi(pk0), bflo(pk1), bfhi(pk1)}, rp = {bflo(pr0), bfhi(pr0), bflo(pr1), bfhi(pr1)};
        float s0, s1, s2 = 0.f, s3 = 0.f, s4 = 0.f, s5 = 0.f;
        s0 = (bb.x * r.x + bb.y * r.y) + (bb.z * r.z + bb.w * r.w);
        s1 = (kt.x * r.x + kt.y * r.y) + (kt.z * r.z + kt.w * r.w);
        if (!odd) {
            const f32x4 wr = lw * r, w01 = lw * wp, ktw = kt * wp, bbw = bb * wp;
            *(LAS u32x2*)(B + SCN_VEC + pr * 512 + 8 * part) = g.kk;
            *(LAS u32x2*)(B + SCN_VEC + pr * 512 + 128 + 8 * part) = (u32x2){cvt_pk_bf16(wr.x, wr.y), cvt_pk_bf16(wr.z, wr.w)};
            const u32x4 wl = {cvt_pk_bf16(w01.x, 0.f), cvt_pk_bf16(w01.y, 0.f), cvt_pk_bf16(w01.z, 0.f), cvt_pk_bf16(w01.w, 0.f)};
            *(LAS u32x4*)(B + SCN_WLO + pr * 272 + 16 * part) = wl;
            *(LAS u32x4*)(B + SCN_WHI + pr * 272 + 16 * part) = (u32x4){wl.x << 16, wl.y << 16, wl.z << 16, wl.w << 16};
            LAS unsigned* kb = (LAS unsigned*)(B + SCN_KB + pr * 544 + 32 * part);
            kb[0] = cvt_pk_bf16(ktw.x, -bbw.x); kb[2] = cvt_pk_bf16(ktw.y, -bbw.y); kb[4] = cvt_pk_bf16(ktw.z, -bbw.z); kb[6] = cvt_pk_bf16(ktw.w, -bbw.w);
            *(LAS f32x4*)(B + SCN_V + pr * 512 + 16 * part) = v;
            s2 = (kt.x * kkp.x + kt.y * kkp.y) + (kt.z * kkp.z + kt.w * kkp.w);
            s3 = (bb.x * kkp.x + bb.y * kkp.y) + (bb.z * kkp.z + bb.w * kkp.w);
            s4 = (ktw.x * rp.x + ktw.y * rp.y) + (ktw.z * rp.z + ktw.w * rp.w);
            s5 = (bbw.x * rp.x + bbw.y * rp.y) + (bbw.z * rp.z + bbw.w * rp.w);
        } else {
            const f32x4 qk = wp * kk, qr = wp * lw * r;
            *(LAS u32x2*)(B + SCN_VEC + pr * 512 + 256 + 8 * part) = (u32x2){cvt_pk_bf16(qk.x, qk.y), cvt_pk_bf16(qk.z, qk.w)};
            *(LAS u32x2*)(B + SCN_VEC + pr * 512 + 384 + 8 * part) = (u32x2){cvt_pk_bf16(qr.x, qr.y), cvt_pk_bf16(qr.z, qr.w)};
            LAS unsigned* kb = (LAS unsigned*)(B + SCN_KB + pr * 544 + 32 * part);
            kb[1] = cvt_pk_bf16(kt.x, -bb.x); kb[3] = cvt_pk_bf16(kt.y, -bb.y); kb[5] = cvt_pk_bf16(kt.z, -bb.z); kb[7] = cvt_pk_bf16(kt.w, -bb.w);
            *(LAS f32x4*)(B + SCN_V + pr * 512 + 256 + 16 * part) = v;
        }
#pragma unroll
        for (int o = 0; o < 1; ++o) { s0 = row16_sum(s0); s1 = row16_sum(s1); s2 = row16_sum(s2); s3 = row16_sum(s3); s4 = row16_sum(s4); s5 = row16_sum(s5); }
        if (part == 0) { LAS float* sc = (LAS float*)(B + SCN_SC + pr * 32);
            if (!odd) { sc[0] = s0; sc[1] = s1; sc[2] = s2; sc[3] = s3; sc[4] = s4; sc[5] = s5; } else { sc[6] = s0; sc[7] = s1; } } };
    auto ystore = [&](int cchunk, int ls) { const LAS float* Y = (const LAS float*)(L + SCN_YST + (cchunk & 1) * 8192); const int tt = cchunk * 32 + ls; const int t = dir ? (SEQ - 1 - tt) : tt;
        const f32x4 yv = *(const LAS f32x4*)(Y + ls * 64 + 4 * part);
        *(u32x2*)(YS + (size_t)(b * SEQ + t) * 1024 + h * 64 + 4 * part) = (u32x2){cvt_pk_bf16(yv.x, yv.y), cvt_pk_bf16(yv.z, yv.w)}; };
    const int lane = F.lane, m = lane & 15, q = lane >> 4, wv = F.wave & 3;
    const bool act = (q == (m >> 2));
    const int o_vec = SCN_VEC + (m & 3) * 128 + 8 * q, o_v = SCN_V + 4 * (16 * wv + m);
    int o_w0[4], o_w1[4], o_kb[4];
#pragma unroll
    for (int t = 0; t < 4; ++t) { const int j = 16 * t + m, wsel = ((m & 1) ? SCN_WHI : SCN_WLO) + 4 * j, zero = SCN_WLO + 256;
        o_w0[t] = (act && (m & 3) < 2) ? wsel : zero; o_w1[t] = (act && (m & 3) >= 2) ? wsel : zero; o_kb[t] = SCN_KB + ((q == 0) ? 8 * j : 512); }
    f32x4 St[4];
#pragma unroll
    for (int t = 0; t < 4; ++t) St[t] = (f32x4){0.f, 0.f, 0.f, 0.f};
    ScanRegs gA{}, gB{};
    const bool loader = tid >= 256;
    if (loader) __builtin_amdgcn_s_setprio(1);
    if (loader) { gload(gA, 0, lsA); gload(gB, 0, lsB); lstore(gA, 0, lsA); lstore(gB, 0, lsB); gload(gA, 1, lsA); gload(gB, 1, lsB); }
    __syncthreads();
    for (int cch = 0; cch < 64; ++cch) {
        const int bi = cch & 1;
        if (!loader) {
            const LAS unsigned char* B = L + bi * SCN_BUF; LAS float* YST = (LAS float*)(L + SCN_YST + bi * 8192);
            const LAS unsigned char* p_vec = B + o_vec; const LAS unsigned char* p_v = B + o_v;
            const LAS unsigned char* p_w0[4]; const LAS unsigned char* p_w1[4]; const LAS unsigned char* p_kb[4];
#pragma unroll
            for (int t = 0; t < 4; ++t) { p_w0[t] = B + o_w0[t]; p_w1[t] = B + o_w1[t]; p_kb[t] = B + o_kb[t]; }
#pragma unroll
            for (int p = 0; p < 16; ++p) {
                const u32x2 a0 = *(const LAS u32x2*)(p_vec + p * 512), a1 = *(const LAS u32x2*)(p_vec + p * 512 + 32), a2 = *(const LAS u32x2*)(p_vec + p * 512 + 64), a3 = *(const LAS u32x2*)(p_vec + p * 512 + 96);
                unsigned w0[4], w1[4]; u32x2 kb[4];
#pragma unroll
                for (int t = 0; t < 4; ++t) { w0[t] = *(const LAS unsigned*)(p_w0[t] + p * 272); w1[t] = *(const LAS unsigned*)(p_w1[t] + p * 272); kb[t] = *(const LAS u32x2*)(p_kb[t] + p * 544); }
                const float v0 = *(const LAS float*)(p_v + p * 512), v1 = *(const LAS float*)(p_v + p * 512 + 256);
                const f32x4 c0 = *(const LAS f32x4*)(B + SCN_SC + p * 32), c1 = *(const LAS f32x4*)(B + SCN_SC + p * 32 + 16);
                unsigned bp[4][2];
#pragma unroll
                for (int t = 0; t < 4; ++t) { bp[t][0] = cvt_pk_bf16_hz(St[t][0], St[t][1]); bp[t][1] = cvt_pk_bf16_hz(St[t][2], St[t][3]); }
                f32x4 P = {0.f, 0.f, 0.f, 0.f};
                P = __builtin_amdgcn_mfma_f32_16x16x32_bf16(__builtin_bit_cast(bf16x8, ((u32x4){a0.x, a0.y, a1.x, a1.y})), __builtin_bit_cast(bf16x8, ((u32x4){bp[0][0], bp[0][1], bp[1][0], bp[1][1]})), P, 0, 0, 0);
                P = __builtin_amdgcn_mfma_f32_16x16x32_bf16(__builtin_bit_cast(bf16x8, ((u32x4){a2.x, a2.y, a3.x, a3.y})), __builtin_bit_cast(bf16x8, ((u32x4){bp[2][0], bp[2][1], bp[3][0], bp[3][1]})), P, 0, 0, 0);
                const float sa0 = P[0];
                const float sa1 = P[2] - sa0 * c0.w + v0 * c0.z;
                const float y0 = P[1] - sa0 * c0.x + v0 * c0.y;
                const float y1 = P[3] - sa0 * c1.y + v0 * c1.x - sa1 * c1.z + v1 * c1.w;
                YST[(2 * p) * 64 + 16 * wv + m] = y0; YST[(2 * p + 1) * 64 + 16 * wv + m] = y1;
                const unsigned vs0 = cvt_pk_bf16_hz(v0, sa0), vs1 = cvt_pk_bf16_hz(v1, sa1);
#pragma unroll
                for (int t = 0; t < 4; ++t)
                    St[t] = __builtin_amdgcn_mfma_f32_16x16x32_bf16(__builtin_bit_cast(bf16x8, ((u32x4){w0[t], w1[t], kb[t].x, kb[t].y})), __builtin_bit_cast(bf16x8, ((u32x4){bp[t][0], bp[t][1], vs0, vs1})), (f32x4){0.f, 0.f, 0.f, 0.f}, 0, 0, 0);
            }
        } else {
            ConvQ cq{}; f32x4 cv[16]; bool conv = false;
            if constexpr (CONV) { const int n0 = (cch * 49) >> 6, n1 = ((cch + 1) * 49) >> 6; const int it = F.vcu * 4 + (F.wave - 4) + 1024 * n0;
                conv = (n1 > n0) && it < 65 * 768;
                if (conv) { cq = conv_quad_item(F.in, F.ws, it, lane); conv_quad_load(cq, cv); } }
            if (cch + 1 < 64) { lstore(gA, bi ^ 1, lsA); lstore(gB, bi ^ 1, lsB); }
            if (cch + 2 < 64) { gload(gA, cch + 2, lsA); gload(gB, cch + 2, lsB); }
            if (cch >= 1) { ystore(cch - 1, lsA); ystore(cch - 1, lsB); }
            if constexpr (CONV) { if (conv) conv_quad_store(cq, cv); }
        }
        __syncthreads();
    }
    __builtin_amdgcn_s_setprio(0);
    if (loader) { ystore(63, lsA); ystore(63, lsB); }
}

__device__ __forceinline__ void p5_post(Frame& F) {
    unsigned char* ws = F.ws; const int lane = F.lane;
    const bf16* YS = (const bf16*)(ws + WS_YS); const bf16* R = (const bf16*)(ws + WS_R); const bf16* V = (const bf16*)(ws + WS_V); const bf16* KT = (const bf16*)(ws + WS_KT);
    const bf16* GG = (const bf16*)(ws + WS_G); bf16* YR = (bf16*)(ws + WS_YR);
    const float* r_k = F.in[19]; const float* lg = F.in[20]; const float* lb = F.in[21];
    for (int t = F.gw; t < NTOK; t += F.NGW) {
        const size_t o = (size_t)t * 1024 + 16 * lane;
        float y[16], r[16], k0[16], k1[16], v[16], g[16];
#pragma unroll
        for (int hh = 0; hh < 2; ++hh) { float ya[8], yb[8]; unpack8(*(const u32x4*)(YS + o + 8 * hh), ya); unpack8(*(const u32x4*)(YS + (size_t)NTOK * 1024 + o + 8 * hh), yb);
#pragma unroll
            for (int j = 0; j < 8; ++j) y[8 * hh + j] = ya[j] + yb[j]; }
#pragma unroll
        for (int hh = 0; hh < 2; ++hh) { float tmp[8];
            unpack8(*(const u32x4*)(R + o + 8 * hh), tmp);
#pragma unroll
            for (int j = 0; j < 8; ++j) r[8 * hh + j] = tmp[j];
            unpack8(*(const u32x4*)(KT + o + 8 * hh), tmp);
#pragma unroll
            for (int j = 0; j < 8; ++j) k0[8 * hh + j] = tmp[j];
            unpack8(*(const u32x4*)(KT + (size_t)NTOK * 1024 + o + 8 * hh), tmp);
#pragma unroll
            for (int j = 0; j < 8; ++j) k1[8 * hh + j] = tmp[j];
            unpack8(*(const u32x4*)(V + o + 8 * hh), tmp);
#pragma unroll
            for (int j = 0; j < 8; ++j) v[8 * hh + j] = tmp[j];
            unpack8(*(const u32x4*)(GG + o + 8 * hh), tmp);
#pragma unroll
            for (int j = 0; j < 8; ++j) g[8 * hh + j] = tmp[j]; }
        float s = 0.f, cf = 0.f;
#pragma unroll
        for (int j = 0; j < 16; ++j) { s += y[j]; cf += r[j] * (k0[j] + k1[j]) * r_k[16 * lane + j]; }
        s = quad_sum(s); cf = quad_sum(cf);
        const float mu = s * (1.f / 64.f); float q2 = 0.f;
#pragma unroll
        for (int j = 0; j < 16; ++j) { y[j] -= mu; q2 += y[j] * y[j]; }
        q2 = quad_sum(q2);
        const float rs = __builtin_amdgcn_rsqf(q2 * (1.f / 64.f) + GN_EPS);
#pragma unroll
        for (int j = 0; j < 16; ++j) y[j] = (y[j] * rs * lg[16 * lane + j] + lb[16 * lane + j] + cf * v[j]) * g[j];
        store16(YR + o, y);
    }
}

__device__ __forceinline__ void p8_route(Frame& F) {
    unsigned char* ws = F.ws; const int lane = F.lane, r = lane & 31, hh = lane >> 5, wave = F.wave;
    const bf16* H1 = (const bf16*)(ws + WS_HRES); const bf16* WF = (const bf16*)(ws + WS_WRT);
    LAS float* LG = (LAS float*)F.lds;
    LAS float* SQ = LG + 4 * 64 * 64;
    LAS int* hist = (LAS int*)(SQ + 256);
    if (F.tid < 64) hist[F.tid] = 0;
    { const int th = wave >> 2, kq = wave & 3; const int tok0 = F.vcu * 64 + th * 32;
        f32x16 a0, a1;
#pragma unroll
        for (int j = 0; j < 16; ++j) { a0[j] = 0.f; a1[j] = 0.f; }
        float sq = 0.f;
        const bf16* hp = H1 + (size_t)(tok0 + r) * DM + kq * 512 + 8 * hh;
        const bf16* wf = WF + (size_t)kq * 32 * 2048 + lane * 8;
#pragma unroll 4
        for (int s = 0; s < 32; ++s) {
            const u32x4 aw = *(const u32x4*)(hp + 16 * s); const bf16x8 a = __builtin_bit_cast(bf16x8, aw);
            { float f[8]; unpack8(aw, f);
#pragma unroll
              for (int j = 0; j < 8; ++j) sq += f[j] * f[j]; }
            const bf16x8 bh0 = *(const bf16x8*)(wf + 2048 * s), bl0 = *(const bf16x8*)(wf + 2048 * s + 512), bh1 = *(const bf16x8*)(wf + 2048 * s + 1024), bl1 = *(const bf16x8*)(wf + 2048 * s + 1536);
            a0 = __builtin_amdgcn_mfma_f32_32x32x16_bf16(a, bh0, a0, 0, 0, 0); a0 = __builtin_amdgcn_mfma_f32_32x32x16_bf16(a, bl0, a0, 0, 0, 0);
            a1 = __builtin_amdgcn_mfma_f32_32x32x16_bf16(a, bh1, a1, 0, 0, 0); a1 = __builtin_amdgcn_mfma_f32_32x32x16_bf16(a, bl1, a1, 0, 0, 0);
        }
        sq += __shfl_xor(sq, 32);
        if (hh == 0) SQ[kq * 64 + th * 32 + r] = sq;
        LAS float* lp = LG + (kq * 64 + th * 32) * 64;
#pragma unroll
        for (int j = 0; j < 16; ++j) { const int row = (j & 3) + 8 * (j >> 2) + 4 * hh; lp[row * 64 + r] = a0[j]; lp[row * 64 + 32 + r] = a1[j]; }
    }
    __syncthreads();
    int* TOPI = (int*)(ws + WS_TOPI); float* TOPG = (float*)(ws + WS_TOPG); int* WGCNT = (int*)(ws + WS_WGCNT);
    unsigned char* U8 = ws + WS_U; const float* gffn = F.in[25]; const float* brt = F.in[27];
    int mycnt = 0;
    {
        float score[8], sel[8], gs[8], gsum[8], rstd[8]; int myk[8];
#pragma unroll
        for (int q = 0; q < 8; ++q) { const int tl = wave * 8 + q;
            const float ss = (SQ[tl] + SQ[64 + tl]) + (SQ[128 + tl] + SQ[192 + tl]);
            rstd[q] = __builtin_amdgcn_rsqf(ss * (1.f / DM) + RMS_EPS);
            const float lg = ((LG[tl * 64 + lane] + LG[(64 + tl) * 64 + lane]) + (LG[(128 + tl) * 64 + lane] + LG[(192 + tl) * 64 + lane])) * rstd[q];
            score[q] = 1.0f / (1.0f + __expf(-lg)); sel[q] = score[q] + brt[lane]; gs[q] = 0.f; gsum[q] = 0.f; myk[q] = -1; }
#pragma unroll
        for (int k = 0; k < 8; ++k) {
            float bv[8]; int bi[8];
#pragma unroll
            for (int q = 0; q < 8; ++q) { bv[q] = sel[q]; bi[q] = lane; }
#define TOP8_STEP(OV, OI) { _Pragma("unroll") for (int q = 0; q < 8; ++q) { const float ov_ = (OV); const int oi_ = (OI); if (ov_ > bv[q] || (ov_ == bv[q] && oi_ < bi[q])) { bv[q] = ov_; bi[q] = oi_; } } }
            TOP8_STEP(dppf<DPP_X1>(bv[q]), dppi<DPP_X1>(bi[q]))
            TOP8_STEP(dppf<DPP_X2>(bv[q]), dppi<DPP_X2>(bi[q]))
            TOP8_STEP(dppf<DPP_HM>(bv[q]), dppi<DPP_HM>(bi[q]))
            TOP8_STEP(dppf<DPP_RM>(bv[q]), dppi<DPP_RM>(bi[q]))
#undef TOP8_STEP
#pragma unroll
            for (int o = 16; o < 64; o <<= 1) {
                float ov[8]; int oi[8];
#pragma unroll
                for (int q = 0; q < 8; ++q) { ov[q] = __shfl_xor(bv[q], o); oi[q] = __shfl_xor(bi[q], o); }
#pragma unroll
                for (int q = 0; q < 8; ++q) if (ov[q] > bv[q] || (ov[q] == bv[q] && oi[q] < bi[q])) { bv[q] = ov[q]; bi[q] = oi[q]; } }
            float sc[8];
#pragma unroll
            for (int q = 0; q < 8; ++q) sc[q] = __shfl(score[q], bi[q]);
#pragma unroll
            for (int q = 0; q < 8; ++q) { gsum[q] += sc[q]; const bool hit = (lane == bi[q]);
                sel[q] = hit ? -1e30f : sel[q]; myk[q] = hit ? k : myk[q]; gs[q] = hit ? sc[q] : gs[q]; mycnt += hit ? 1 : 0; }
        }
#pragma unroll
        for (int q = 0; q < 8; ++q) { const int t = F.vcu * 64 + wave * 8 + q;
            if (myk[q] >= 0) { TOPI[t * 8 + myk[q]] = lane; TOPG[t * 8 + myk[q]] = gs[q] / gsum[q] * 2.5f; } }
        f32x4 gg[8];
#pragma unroll
        for (int j = 0; j < 8; ++j) gg[j] = ((const f32x4*)gffn + lane)[64 * j];
#pragma unroll
        for (int qb4 = 0; qb4 < 2; ++qb4) { u32x2 vw[4][8];
#pragma unroll
            for (int q = 0; q < 4; ++q) { const u32x2* xr = (const u32x2*)(H1 + (size_t)(F.vcu * 64 + wave * 8 + qb4 * 4 + q) * DM) + lane;
#pragma unroll
                for (int j = 0; j < 8; ++j) vw[q][j] = xr[64 * j]; }
#pragma unroll
            for (int q = 0; q < 4; ++q) { const float rs = rstd[qb4 * 4 + q]; unsigned* o4 = (unsigned*)(U8 + (size_t)(F.vcu * 64 + wave * 8 + qb4 * 4 + q) * DM) + lane;
#pragma unroll
                for (int j = 0; j < 8; ++j) { const f32x4 v = {bflo(vw[q][j].x), bfhi(vw[q][j].x), bflo(vw[q][j].y), bfhi(vw[q][j].y)}; o4[64 * j] = pk4_fp8(v.x * rs * gg[j].x, v.y * rs * gg[j].y, v.z * rs * gg[j].z, v.w * rs * gg[j].w); } } }
    }
    atomicAdd((int*)&hist[lane], mycnt);
    __syncthreads();
    if (F.tid < 64) WGCNT[F.vcu * 64 + F.tid] = hist[F.tid];
}

__device__ __forceinline__ void p10_slots(Frame& F) {
    unsigned char* ws = F.ws; const int tid = F.tid;
    const int* TOPI = (const int*)(ws + WS_TOPI); const float* TOPG = (const float*)(ws + WS_TOPG); const int* WGCNT = (const int*)(ws + WS_WGCNT);
    int* MISC = (int*)(ws + WS_MISC); int* STOK = (int*)(ws + WS_SLOT_TOK); int* SDST = (int*)(ws + WS_SLOT_DST); float* SG = (float*)(ws + WS_SLOT_G);
    LAS int* L = (LAS int*)F.lds;
    const int G = F.G, me = F.vcu;
    { const int e = tid & 63, part = tid >> 6; int tot = 0, bef = 0;
      for (int w = part * 32; w < part * 32 + 32 && w < G; ++w) { const int cnt = WGCNT[w * 64 + e]; tot += cnt; if (w < me) bef += cnt; }
      L[part * 64 + e] = tot; L[512 + part * 64 + e] = bef; }
    __syncthreads();
    if (tid < 64) { int tot = 0, bef = 0;
#pragma unroll
        for (int p = 0; p < 8; ++p) { tot += L[p * 64 + tid]; bef += L[512 + p * 64 + tid]; }
        L[1024 + tid] = tot; L[1088 + tid] = bef; L[1216 + tid] = (tot + 255) & ~255; }
    __syncthreads();
    if (tid == 0) { int acc = 0; for (int e = 0; e < 64; ++e) { L[1152 + e] = acc; acc += L[1216 + e]; } }
    { const int t = me * 64 + (tid >> 3); L[1280 + tid] = TOPI[t * 8 + (tid & 7)]; }
    __syncthreads();
    { const int e = L[1280 + tid]; int rank = 0;
      for (int p = 0; p < tid; ++p) rank += (L[1280 + p] == e) ? 1 : 0;
      const int slot = L[1152 + e] + L[1088 + e] + rank; const int t = me * 64 + (tid >> 3), k = tid & 7;
      STOK[slot] = t; SDST[slot] = t * 9 + k; SG[slot] = TOPG[t * 8 + k]; }
    if (tid < 64) { const int t = me * 64 + tid; STOK[RCAP + t] = t; SDST[RCAP + t] = t * 9 + 8; SG[RCAP + t] = 1.0f; }
    for (int e = me; e < 64; e += G) {
        const int s0 = L[1152 + e] + L[1024 + e], s1 = L[1152 + e] + L[1216 + e];
        for (int s = s0 + tid; s < s1; s += 512) { STOK[s] = 0; SDST[s] = -1; SG[s] = 0.f; } }
    if (me == 0) {
        if (tid < 64) { MISC[MI_TOTAL + tid] = L[1024 + tid]; MISC[MI_PADDED + tid] = L[1216 + tid]; MISC[MI_PSTART + tid] = L[1152 + tid]; }
        if (tid < 64) { const int n0 = L[1152 + tid] >> 8, cntt = L[1216 + tid] >> 8;
            for (int m = 0; m < cntt; ++m) { MISC[MI_TILE_E + n0 + m] = tid; MISC[MI_TILE_R0 + n0 + m] = L[1152 + tid] + 256 * m; }
            const int nr = (L[1152 + 63] + L[1216 + 63]) >> 8;
            MISC[MI_TILE_E + nr + tid] = 64; MISC[MI_TILE_R0 + nr + tid] = RCAP + 256 * tid;
            if (tid == 0) MISC[MI_NT] = nr + 64; }
    }
}

__device__ __forceinline__ void combine_phase(Frame& F) {
    unsigned char* ws = F.ws; const int lane = F.lane;
    const unsigned char* Y = ws + WS_Y; unsigned char* U8 = ws + WS_U; bf16* H = (bf16*)(ws + WS_HRES); const float* gple = F.in[34];
    f32x4 gg[2][4];
#pragma unroll
    for (int hf = 0; hf < 2; ++hf)
#pragma unroll
        for (int q = 0; q < 4; ++q) gg[hf][q] = *(const f32x4*)(gple + hf * 1024 + 16 * lane + 4 * q);
    for (int t = F.gw; t < NTOK; t += F.NGW) {
        u32x4 hw[2][2], yw[2][9];
#pragma unroll
        for (int hf = 0; hf < 2; ++hf) { const bf16* hp = H + (size_t)t * DM + hf * 1024 + 16 * lane; hw[hf][0] = *(const u32x4*)hp; hw[hf][1] = *(const u32x4*)(hp + 8);
#pragma unroll
            for (int k = 0; k < 9; ++k) yw[hf][k] = *(const u32x4*)(Y + ((size_t)t * 9 + k) * 2048 + hf * 1024 + 16 * lane); }
        float a[2][16]; float ss = 0.f;
#pragma unroll
        for (int hf = 0; hf < 2; ++hf) {
            bf16* hp = H + (size_t)t * DM + hf * 1024 + 16 * lane;
            { float lo8[8], hi8[8]; unpack8(hw[hf][0], lo8); unpack8(hw[hf][1], hi8);
#pragma unroll
              for (int j = 0; j < 8; ++j) { a[hf][j] = lo8[j]; a[hf][8 + j] = hi8[j]; } }
#pragma unroll
            for (int k = 0; k < 9; ++k) {
#pragma unroll
                for (int d = 0; d < 4; ++d) { const f32x2 lo = __builtin_amdgcn_cvt_pk_f32_fp8((int)yw[hf][k][d], false), hi = __builtin_amdgcn_cvt_pk_f32_fp8((int)yw[hf][k][d], true);
                    a[hf][4 * d] += lo.x * 0.0625f; a[hf][4 * d + 1] += lo.y * 0.0625f; a[hf][4 * d + 2] += hi.x * 0.0625f; a[hf][4 * d + 3] += hi.y * 0.0625f; } }
#pragma unroll
            for (int q = 0; q < 2; ++q) { u32x4 w; w.x = cvt_pk_bf16(a[hf][8 * q], a[hf][8 * q + 1]); w.y = cvt_pk_bf16(a[hf][8 * q + 2], a[hf][8 * q + 3]); w.z = cvt_pk_bf16(a[hf][8 * q + 4], a[hf][8 * q + 5]); w.w = cvt_pk_bf16(a[hf][8 * q + 6], a[hf][8 * q + 7]);
                *(u32x4*)(hp + 8 * q) = w; }
#pragma unroll
            for (int j = 0; j < 16; ++j) ss += a[hf][j] * a[hf][j];
        }
        const float rstd = __builtin_amdgcn_rsqf(wave_sum(ss) * (1.f / DM) + RMS_EPS);
#pragma unroll
        for (int hf = 0; hf < 2; ++hf) { float c[16];
#pragma unroll
            for (int j = 0; j < 16; ++j) c[j] = a[hf][j] * rstd * gg[hf][j >> 2][j & 3];
            u32x4 w; w.x = pk4_fp8(c[0], c[1], c[2], c[3]); w.y = pk4_fp8(c[4], c[5], c[6], c[7]); w.z = pk4_fp8(c[8], c[9], c[10], c[11]); w.w = pk4_fp8(c[12], c[13], c[14], c[15]);
            *(u32x4*)(U8 + (size_t)t * DM + hf * 1024 + 16 * lane) = w; }
    }
}

__device__ __forceinline__ void final_phase(Frame& F) {
    const float* g = F.in[37];
    f32x4 gg[8];
#pragma unroll
    for (int j = 0; j < 8; ++j) gg[j] = ((const f32x4*)g + F.lane)[64 * j];
    for (int m = F.gw; m < NTOK; m += 2 * F.NGW) {
        const int m2 = m + F.NGW;
        u32x2 hw[2][8];
#pragma unroll
        for (int r = 0; r < 2; ++r) { const int mm = r ? m2 : m; if (mm < NTOK) { const u32x2* hr = (const u32x2*)((const bf16*)(F.ws + WS_HRES) + (size_t)mm * DM) + F.lane;
#pragma unroll
            for (int j = 0; j < 8; ++j) hw[r][j] = hr[64 * j]; } }
#pragma unroll
        for (int r = 0; r < 2; ++r) { const int mm = r ? m2 : m; if (mm < NTOK) {
            f32x4 v[8]; float s = 0.f;
#pragma unroll
            for (int j = 0; j < 8; ++j) { v[j] = (f32x4){bflo(hw[r][j].x), bfhi(hw[r][j].x), bflo(hw[r][j].y), bfhi(hw[r][j].y)}; s += (v[j].x * v[j].x + v[j].y * v[j].y) + (v[j].z * v[j].z + v[j].w * v[j].w); }
            const float rstd = __builtin_amdgcn_rsqf(wave_sum(s) * (1.f / DM) + RMS_EPS);
            f32x4* xr = (f32x4*)(F.out + (size_t)mm * DM) + F.lane;
#pragma unroll
            for (int j = 0; j < 8; ++j) xr[64 * j] = v[j] * rstd * gg[j]; } }
    }
}

constexpr int NPHASE = 15;
__global__ void __launch_bounds__(512, 2) fwd_kernel(Args args) {
    extern __shared__ __attribute__((aligned(16))) unsigned char lds_raw[];
    Frame F;
    F.lds = (LAS unsigned char*)lds_raw; F.ws = args.ws; F.in = args.in; F.out = args.out;
    F.tid = threadIdx.x; F.lane = F.tid & 63; F.wave = __builtin_amdgcn_readfirstlane(F.tid >> 6);
    F.G = gridDim.x; { const int bx = blockIdx.x; F.vcu = (F.G % 8 == 0) ? (bx % 8) * (F.G / 8) + bx / 8 : bx; }
    F.gw = F.vcu * 8 + F.wave; F.NGW = F.G * 8;
    unsigned char* ws = args.ws;
    volatile LAS unsigned* MISCW = (volatile LAS unsigned*)(F.lds + LDSCTL_OFF);
    if (F.tid < 64) MISCW[F.tid] = 0u;
    __syncthreads();
    const int lo = args.ph_lo, hi = args.ph_hi;
    XcdBarrier bar; bar.bar = (unsigned*)(ws + WS_CTL) + CW_BAR; bar.x = 0; bar.st = nullptr;
    if (hi - lo > 1) bar = xcd_barrier_post((unsigned*)(ws + WS_CTL) + CW_BAR, MISCW + 8);
#ifdef ONLY_PHASE
#define IN(k) ((k) == ONLY_PHASE && lo <= (k) && (k) < hi)
#else
#define IN(k) (lo <= (k) && (k) < hi)
#endif
#define SEAM(k) do { if (IN(k) && IN((k) + 1)) xcd_barrier(bar); } while (0)
    using namespace pg8;
    LAS unsigned char* lds = F.lds;
    const int G = F.G, bx = (int)blockIdx.x;

    if (IN(0)) { p0_prologue(F); } SEAM(0);
    if (IN(1)) {
        { SchedDense S{ws + WS_U, 2048, ws + WS_W1, 2048, 32, 64, ZLD / 256, G, bx, 2, 0};
          EpiZ E{(bf16*)(ws + WS_Z), (unsigned*)(ws + WS_CTL) + CW_QKN};
          gemm_phase(lds, S, E); }
        {
          SchedDenseRange S{{ws + WS_U8E, 2048, ws + WS_W1G8, 2048, 16, 64, GLD / 256, G, bx, 1, 0x79797979}, bx < 128 ? 640 + bx * 3 : (bx - 128) * 5, bx < 128 ? 3 : 5};
          EpiGate E{ws + WS_GATES};
          gemm_phase<EpiGate, SchedDenseRange, true>(lds, S, E); }
    } SEAM(1);
    if (IN(2)) { p2_shift(F); } SEAM(2);
    if (IN(3)) {
#ifndef NO_LORA
        { SchedLora S{(const bf16*)(ws + WS_AP), (const bf16*)(ws + WS_WL), 0, 8, G, F.vcu, 256};
          EpiLoraW E{(bf16*)(ws + WS_WD), F.in[12]};
          gemm_phase(lds, S, E); }
        { SchedLora S{(const bf16*)(ws + WS_AP), (const bf16*)(ws + WS_WL), 8, 8, G, F.vcu, 256};
          EpiLoraA E{(bf16*)(ws + WS_KT), (bf16*)(ws + WS_BV), (const bf16*)(ws + WS_KS), (const bf16*)(ws + WS_KK), F.in[14], F.in[18]};
          gemm_phase(lds, S, E); }
        { SchedLora S{(const bf16*)(ws + WS_AP), (const bf16*)(ws + WS_WL), 16, 4, G, F.vcu, 256};
          EpiLoraG E{(bf16*)(ws + WS_G)};
          gemm_phase(lds, S, E); }
#endif
        __syncthreads();
#ifndef NO_ATTN
        attn_phase(F);
#endif
    } SEAM(3);
    if (IN(4)) { scan_phase<true>(F); } SEAM(4);
    if (IN(5)) { p5_post(F); } SEAM(5);
    if (IN(6)) {
        SchedPair S{(const bf16*)(ws + WS_YA), (const bf16*)(ws + WS_YR), 1024, 1024, (const bf16*)(ws + WS_WBR), (const bf16*)(ws + WS_WBR) + (size_t)2048 * 1024, 1024, 16, 16, 64, 8, G, bx};
        EpiMerge E{(bf16*)(ws + WS_MERGED), ws + WS_GATES};
        gemm_phase(lds, S, E);
    } SEAM(6);
    if (IN(7)) {
        SchedDense S{ws + WS_MERGED, 2048, ws + WS_WOUT, 2048, 32, 64, 8, G, bx, 2, 0};
        EpiResF32 E{(bf16*)(ws + WS_HRES), F.in[0]};
        gemm_phase(lds, S, E);
    } SEAM(7);
    if (IN(8)) { p8_route(F); } SEAM(8);
    if (IN(9)) { p10_slots(F); } SEAM(9);
    if (IN(10)) {
        SchedMoeUp S{ws + WS_U, ws + WS_WUP, (const int*)(ws + WS_SLOT_TOK), (const int*)(ws + WS_MISC), G, F.vcu, 2048, 0x79797979};
        EpiUp E{ws + WS_HB};
        gemm_phase<EpiUp, SchedMoeUp, true>(lds, S, E);
        { const int ntl = ((const int*)(ws + WS_MISC))[MI_NT] * 4, rem = ntl % G, nshort = rem ? G - rem : G;
          SchedStride S2{{ws + WS_PB, 256, ws + WS_WPP, 2048, 4, 64, 8, G, F.vcu, 2, 0}, rem ? F.vcu - rem : F.vcu, nshort};
          EpiP E2{ws + WS_PBUF};
          gemm_phase(lds, S2, E2); }
    } SEAM(10);
    if (IN(11)) {
        SchedMoeDown S{ws + WS_HB, ws + WS_WDN, (const int*)(ws + WS_MISC), G, F.vcu, 512, 0x7A7A7A7A};
        EpiDown E{ws + WS_Y, (const int*)(ws + WS_SLOT_DST), (const float*)(ws + WS_SLOT_G)};
        gemm_phase<EpiDown, SchedMoeDown, true>(lds, S, E);
    } SEAM(11);
    if (IN(12)) { combine_phase(F); } SEAM(12);
    if (IN(13)) {
        { SchedDense S{ws + WS_U, 2048, ws + WS_WPG, 2048, 16, 64, 8, G, bx, 1, 0x79797979};
          EpiPleG E{ws + WS_PBUF, (bf16*)(ws + WS_HRES)};
          gemm_phase<EpiPleG, SchedDense, true>(lds, S, E); }
    } SEAM(13);
    if (IN(14)) { final_phase(F); }
#undef IN
#undef SEAM
}

extern "C" void kernel_launch(void* const* d_in, const int* in_sizes, int n_in, void* d_out, int out_size, void* d_ws, size_t ws_size, hipStream_t stream) {
    static int grid = 0;
    if (grid == 0) {
        if (n_in != 38 || out_size != NTOK * DM || ws_size < WS_END) { fprintf(stderr, "kernel_launch: unexpected problem (n_in %d, out %d, ws %zu)\n", n_in, out_size, ws_size); grid = -1; return; }
        if (hipFuncSetAttribute((const void*)fwd_kernel, hipFuncAttributeMaxDynamicSharedMemorySize, LDS_BYTES) != hipSuccess) { fprintf(stderr, "kernel_launch: hipFuncSetAttribute failed\n"); grid = -1; return; }
        int dev = 0, cus = 0, per_cu = 0;
        (void)hipGetDevice(&dev); (void)hipDeviceGetAttribute(&cus, hipDeviceAttributeMultiprocessorCount, dev);
        (void)hipOccupancyMaxActiveBlocksPerMultiprocessor(&per_cu, (const void*)fwd_kernel, 512, LDS_BYTES);
        (void)hipGetLastError();
        if (per_cu < 1 || cus < 256) fprintf(stderr, "kernel_launch: note: occupancy %d blocks/CU, %d CUs\n", per_cu, cus);
        grid = 256;
    }
    if (grid < 0) return;
    (void)hipMemsetAsync((char*)d_ws + WS_CTL, 0, CTL_BYTES, stream);
    Args a{};
    for (int i = 0; i < 38; ++i) a.in[i] = (const float*)d_in[i];
    a.out = (float*)d_out; a.ws = (unsigned char*)d_ws;
#if MK_ONE_LAUNCH
    a.ph_lo = 0; a.ph_hi = NPHASE;
    hipLaunchKernelGGL(fwd_kernel, dim3(grid), dim3(512), LDS_BYTES, stream, a);
#else
    for (int p = 0; p < NPHASE; ++p) { a.ph_lo = p; a.ph_hi = p + 1; hipLaunchKernelGGL(fwd_kernel, dim3(grid), dim3(512), LDS_BYTES, stream, a); }
#endif
}
```
